# Optimizing an MI355X kernel written in HIP

```python
import jax, jax.numpy as jnp
from jax import lax
import numpy as np

D_MODEL = 1024
BATCH = 8
SEQ = 2048
DEPTH = 1

GRID_W = 64
CTX_LEN = 256
LRU_WIDTH = D_MODEL
LRU_HEADS = 8
LRU_HEAD_DIM = LRU_WIDTH // LRU_HEADS
CONV_WIDTH = 4
CONV_PAD_LEFT = 1
LRU_C = 8.0
SGU_WIDTH = D_MODEL
SGU_GROUPS = 8
SGU_GROUP_DIM = SGU_WIDTH // SGU_GROUPS
CHUNK = 128
D_MIX = LRU_WIDTH + SGU_WIDTH
D_IN = 2 * LRU_WIDTH + 3 * SGU_WIDTH
NORM_EPS = 1e-6
LN_EPS = 1e-5

kernel_name = "hybrid_rglru_chunk_sgu_dit_block"


def rmsnorm(x, g):
    xf = x.astype(jnp.float32)
    y = xf * lax.rsqrt(jnp.mean(xf * xf, axis=-1, keepdims=True) + NORM_EPS)
    return (y * g.astype(jnp.float32)).astype(x.dtype)


def ada_mod(cond, w, b):
    m = jax.nn.silu(cond) @ w + b
    return jnp.split(m, 3, axis=-1)


def project(h, shift, scale, norm_g, w_in):
    hn = rmsnorm(h, norm_g) * (1.0 + scale) + shift
    return hn @ w_in


def short_conv(xa, w, b):
    L = xa.shape[1]
    xp = jnp.pad(xa, ((0, 0), (CONV_PAD_LEFT, CONV_WIDTH - 1 - CONV_PAD_LEFT), (0, 0)))
    y = xp[:, 0:L] * w[0]
    for k in range(1, CONV_WIDTH):
        y = y + xp[:, k:k + L] * w[k]
    return y + b


def _lin_combine(e1, e2):
    a1, b1 = e1
    a2, b2 = e2
    return a1 * a2, a2 * b1 + b2


def rglru_direction(xc, h0, wa, ba, wx, bx, lam, reverse):
    Bn, L, _ = xc.shape
    xh = xc.reshape(Bn, L, LRU_HEADS, LRU_HEAD_DIM)
    r = jax.nn.sigmoid(jnp.einsum('blhi,hij->blhj', xh, wa) + ba).reshape(Bn, L, LRU_WIDTH)
    i = jax.nn.sigmoid(jnp.einsum('blhi,hij->blhj', xh, wx) + bx).reshape(Bn, L, LRU_WIDTH)
    log_a = -LRU_C * r * jax.nn.softplus(-lam.astype(jnp.float32))
    a = jnp.exp(log_a)
    u = jnp.sqrt(-jnp.expm1(2.0 * log_a)) * (i * xc)
    a_cum, h = lax.associative_scan(_lin_combine, (a, u), reverse=reverse, axis=1)
    h = h + a_cum * h0[:, None, :]
    final = h[:, 0] if reverse else h[:, -1]
    return h, final


def rglru_bidir(xc, h0f, h0b, wa, ba, wx, bx, lam):
    hf, ff = rglru_direction(xc, h0f, wa[0], ba[0], wx[0], bx[0], lam[0], False)
    hb, fb = rglru_direction(xc, h0b, wa[1], ba[1], wx[1], bx[1], lam[1], True)
    return hf + hb, ff, fb


def chunk_sgu(u, v, ln_g, ln_b, w_s, b_s, n_chunks):
    Bn = u.shape[0]
    vf = v.astype(jnp.float32)
    mu = jnp.mean(vf, axis=-1, keepdims=True)
    var = jnp.mean(jnp.square(vf - mu), axis=-1, keepdims=True)
    vn = (vf - mu) * lax.rsqrt(var + LN_EPS) * ln_g + ln_b
    vc = vn.reshape(Bn, n_chunks, CHUNK, SGU_GROUPS, SGU_GROUP_DIM)
    mixed = jnp.einsum('gpq,bnqgc->bnpgc', w_s, vc) + b_s.T[None, None, :, :, None]
    return u * mixed.reshape(Bn, n_chunks * CHUNK, SGU_WIDTH).astype(u.dtype)


def split_proj(z):
    W, S = LRU_WIDTH, SGU_WIDTH
    return (z[..., :W], z[..., W:2 * W], z[..., 2 * W:2 * W + S],
            z[..., 2 * W + S:2 * W + 2 * S], z[..., 2 * W + 2 * S:])


def mixer_out(y_lru, ga, y_sgu, gb, w_out):
    y = jnp.concatenate([y_lru * jax.nn.silu(ga), y_sgu * jax.nn.silu(gb)], axis=-1)
    return y @ w_out


def setup_inputs(seed: int = 0) -> dict:
    key = jax.random.key(seed)
    ks = jax.random.split(key, 24)
    nrm = jax.random.normal
    a_c = jax.random.uniform(ks[13], (DEPTH, 2, LRU_WIDTH), minval=0.9, maxval=0.999)
    s = a_c ** (1.0 / LRU_C)
    return {
        "x": nrm(ks[0], (BATCH, SEQ, D_MODEL)),
        "c": nrm(ks[1], (BATCH, D_MODEL)),
        "ctx": nrm(ks[2], (BATCH, CTX_LEN, D_MODEL)),
        "c_ctx": nrm(ks[3], (D_MODEL,)),
        "ada_w": nrm(ks[4], (DEPTH, D_MODEL, 3 * D_MODEL)) * (0.5 * D_MODEL ** -0.5),
        "ada_b": 0.01 * nrm(ks[5], (DEPTH, 3 * D_MODEL)),
        "norm_g": 1.0 + 0.05 * nrm(ks[6], (DEPTH, D_MODEL)),
        "w_in": nrm(ks[7], (DEPTH, D_MODEL, D_IN)) * D_MODEL ** -0.5,
        "conv_w": nrm(ks[8], (DEPTH, CONV_WIDTH, LRU_WIDTH)) * CONV_WIDTH ** -0.5,
        "conv_b": 0.01 * nrm(ks[9], (DEPTH, LRU_WIDTH)),
        "lru_wa": nrm(ks[10], (DEPTH, 2, LRU_HEADS, LRU_HEAD_DIM, LRU_HEAD_DIM)) * LRU_HEAD_DIM ** -0.5,
        "lru_ba": 0.01 * nrm(ks[11], (DEPTH, 2, LRU_HEADS, LRU_HEAD_DIM)),
        "lru_wx": nrm(ks[12], (DEPTH, 2, LRU_HEADS, LRU_HEAD_DIM, LRU_HEAD_DIM)) * LRU_HEAD_DIM ** -0.5,
        "lru_bx": 0.01 * nrm(ks[14], (DEPTH, 2, LRU_HEADS, LRU_HEAD_DIM)),
        "lru_lambda": jnp.log(s) - jnp.log1p(-s),
        "sgu_ln_g": 1.0 + 0.05 * nrm(ks[15], (DEPTH, SGU_WIDTH)),
        "sgu_ln_b": 0.01 * nrm(ks[16], (DEPTH, SGU_WIDTH)),
        "sgu_w": nrm(ks[17], (DEPTH, SGU_GROUPS, CHUNK, CHUNK)) * (0.5 * CHUNK ** -0.5),
        "sgu_b": 1.0 + 0.1 * nrm(ks[18], (DEPTH, SGU_GROUPS, CHUNK)),
        "w_out": nrm(ks[19], (DEPTH, D_MIX, D_MODEL)) * D_MIX ** -0.5,
        "final_g": 1.0 + 0.05 * nrm(ks[20], (D_MODEL,)),
    }


def reference(x, c, ctx, c_ctx, ada_w, ada_b, norm_g, w_in, conv_w, conv_b, lru_wa, lru_ba,
              lru_wx, lru_bx, lru_lambda, sgu_ln_g, sgu_ln_b, sgu_w, sgu_b, w_out, final_g):
    Bn, L, _ = x.shape
    rows = L // GRID_W
    n_chunks = rows * GRID_W // CHUNK
    n_ctx_chunks = ctx.shape[1] // CHUNK
    zeros = jnp.zeros((Bn, LRU_WIDTH), jnp.float32)
    for layer in range(DEPTH):
        sh_x, sc_x, g_x = ada_mod(c[:, None, :], ada_w[layer], ada_b[layer])
        sh_c, sc_c, g_c = ada_mod(c_ctx[None, None, :], ada_w[layer], ada_b[layer])
        lru_p = (lru_wa[layer], lru_ba[layer], lru_wx[layer], lru_bx[layer], lru_lambda[layer])
        last = layer == DEPTH - 1

        ctx_cols = LRU_WIDTH if last else D_IN
        zc = project(ctx, sh_c, sc_c, norm_g[layer], w_in[layer][:, :ctx_cols])
        xc_c = short_conv(zc[..., :LRU_WIDTH], conv_w[layer], conv_b[layer]).astype(jnp.float32)
        y_c, hf_c, hb_c = rglru_bidir(xc_c, zeros, zeros, *lru_p)

        zx = project(x, sh_x, sc_x, norm_g[layer], w_in[layer])
        xa_x, ga_x, u_x, v_x, gb_x = split_proj(zx)
        xc_x = short_conv(xa_x, conv_w[layer], conv_b[layer]).astype(jnp.float32)
        y_l, _, _ = rglru_bidir(xc_x, hf_c, hb_c, *lru_p)
        y_s = chunk_sgu(jax.nn.gelu(u_x), jax.nn.gelu(v_x), sgu_ln_g[layer], sgu_ln_b[layer],
                        sgu_w[layer], sgu_b[layer], n_chunks)
        x_new = x + g_x * mixer_out(y_l.astype(x.dtype), ga_x, y_s, gb_x, w_out[layer])

        if not last:
            _, ga_c, u_c, v_c, gb_c = split_proj(zc)
            y_sc = chunk_sgu(jax.nn.gelu(u_c), jax.nn.gelu(v_c), sgu_ln_g[layer], sgu_ln_b[layer],
                             sgu_w[layer], sgu_b[layer], n_ctx_chunks)
            ctx = ctx + g_c * mixer_out(y_c.astype(ctx.dtype), ga_c, y_sc, gb_c, w_out[layer])
        x = x_new
    return rmsnorm(x, final_g)
```

```cpp
#include <hip/hip_runtime.h>
#include <hip/hip_cooperative_groups.h>
#include <cstdio>
namespace cg = cooperative_groups;

#define LAS __attribute__((address_space(3)))
typedef unsigned short bf16_t;
typedef short bf16x8 __attribute__((ext_vector_type(8)));
typedef float f32x4 __attribute__((ext_vector_type(4)));
typedef float f32x16 __attribute__((ext_vector_type(16)));
typedef unsigned u32x4 __attribute__((ext_vector_type(4)));
typedef unsigned u32x2 __attribute__((ext_vector_type(2)));
typedef float f32x2 __attribute__((ext_vector_type(2)));

constexpr int NB = 8, SEQ = 2048, DM = 1024, CTXL = 256, DIN = 5120;
constexpr int MROWS = NB * SEQ;
constexpr int CROWS = NB * CTXL;
constexpr int NTHREADS = 512, NWAVES = 8;
#define ZSLAB(slab, row) (((size_t)(slab) * MROWS + (size_t)(row)) * 128)
constexpr float LOG2E = 1.4426950408889634f;

constexpr size_t MiB = 1u << 20;
constexpr size_t WS_ADA = 0;
constexpr size_t WS_BAR = 512 * 1024;
constexpr size_t WS_ADA_CNT = WS_BAR + 32768;
constexpr size_t WS_CTX_CNT = WS_BAR + 32768 + 128;
constexpr size_t WS_BAR_BYTES = 32768 + 256;
constexpr size_t WS_ROWSS = 1 * MiB;
constexpr size_t WS_WINT = 2 * MiB;
constexpr size_t WS_WOUTT = 12 * MiB;
constexpr size_t WS_LRUW = 16 * MiB;
constexpr size_t WS_SGUW = 17 * MiB;
constexpr size_t WS_HN = 20 * MiB;
constexpr size_t WS_HF = 20 * MiB;
constexpr size_t WS_Z = 84 * MiB;
constexpr size_t WS_ZC = 244 * MiB;
constexpr size_t WS_STATS = 248 * MiB;
constexpr size_t WS_END = 250 * MiB;

struct Params {
    const float *x, *c, *ctx, *c_ctx, *ada_w, *ada_b, *norm_g, *w_in, *conv_w, *conv_b, *lru_wa, *lru_ba, *lru_wx, *lru_bx, *lru_lambda,
        *sgu_ln_g, *sgu_ln_b, *sgu_w, *sgu_b, *w_out, *final_g;
    float* out; unsigned char* ws;
    int ph_lo, ph_hi;
    int rep0, rep1, rep2, rep3a, rep3b, rep4;
};

__device__ __forceinline__ unsigned cvt_pk_bf16(float lo, float hi) { unsigned r; asm volatile("v_cvt_pk_bf16_f32 %0, %1, %2" : "=v"(r) : "v"(lo), "v"(hi)); return r; }
__device__ __forceinline__ float bf_lo(unsigned u) { return __uint_as_float(u << 16); }
__device__ __forceinline__ float bf_hi(unsigned u) { return __uint_as_float(u & 0xffff0000u); }
__device__ __forceinline__ float bf2f(bf16_t h) { return __uint_as_float(((unsigned)h) << 16); }
__device__ __forceinline__ bf16_t f2bf(float f) { return (bf16_t)(cvt_pk_bf16(f, 0.f) & 0xffffu); }
__device__ __forceinline__ float wave_sum(float v) {
#pragma unroll
    for (int o = 1; o < 64; o <<= 1) v += __shfl_xor(v, o);
    return v;
}
__device__ __forceinline__ int opaque_tid() { int t = threadIdx.x; asm volatile("" : "+v"(t)); return t; }
#define LDS_BARRIER() do { asm volatile("s_waitcnt lgkmcnt(0)" ::: "memory"); __builtin_amdgcn_s_barrier(); asm volatile("" ::: "memory"); } while (0)
__device__ __forceinline__ float fast_sigmoid(float v) { return __builtin_amdgcn_rcpf(1.0f + __builtin_amdgcn_exp2f(-LOG2E * v)); }
__device__ __forceinline__ float act_silu(float v) { return v * fast_sigmoid(v); }
__device__ __forceinline__ float act_gelu_tanh(float v) {
    constexpr float c1 = -2.0f * LOG2E * 0.7978845608028654f, c2 = c1 * 0.044715f;
    const float t = v * v, p = fmaf(t, c2, c1);
    return v * __builtin_amdgcn_rcpf(1.0f + __builtin_amdgcn_exp2f(v * p));
}
__device__ __forceinline__ float act_gelu_silu(float u, float g) {
    constexpr float c1 = -2.0f * LOG2E * 0.7978845608028654f, c2 = c1 * 0.044715f;
    const float eu = __builtin_amdgcn_exp2f(u * fmaf(u * u, c2, c1)), eg = __builtin_amdgcn_exp2f(g * (-LOG2E));
    return (u * g) * __builtin_amdgcn_rcpf((1.0f + eu) * (1.0f + eg));
}
#define XB_TMO      128
#define XB_XCNT(j)  (256  + 64 * (j))
#define XB_XSUB(j)  (1280 + 64 * (j))
#define XB_XGEN(j)  (2304 + 64 * (j))
#define XB_TOP      3328
#define XB_TOPGEN   3392
#define XCD_BAR_WORDS 3456
#define XB_SPIN_CAP (1u << 18)
__device__ __forceinline__ unsigned xb_ld(unsigned* p)              { return __hip_atomic_load(p, __ATOMIC_RELAXED, __HIP_MEMORY_SCOPE_AGENT); }
__device__ __forceinline__ unsigned xb_add(unsigned* p, unsigned v) { return __hip_atomic_fetch_add(p, v, __ATOMIC_RELAXED, __HIP_MEMORY_SCOPE_AGENT); }
__device__ __forceinline__ unsigned xb_xcc_id() { return (unsigned)__builtin_amdgcn_s_getreg((3 << 11) | 20) & 0xFu; }
#define XB_SPIN(cond, bar) do { unsigned _sp = 0; while (cond) { __builtin_amdgcn_s_sleep(1); \
    if ((++_sp & 255u) == 0u) { if (xb_ld(&(bar)[XB_TMO])) break; if (_sp > XB_SPIN_CAP) { atomicAdd(&(bar)[XB_TMO], 1u); break; } } } } while (0)
struct XcdBarrier { unsigned* bar; unsigned x; volatile LAS unsigned* st; };
__device__ __forceinline__ XcdBarrier xcd_barrier_post(unsigned* bar, volatile LAS unsigned* st) {
    XcdBarrier b; b.bar = bar; b.x = xb_xcc_id(); b.st = st;
    if (threadIdx.x == 0) (void)xb_add(&bar[XB_XCNT(b.x)], 1u);
    return b;
}
__device__ __forceinline__ void xcd_barrier_complete(unsigned* bar, unsigned x, unsigned& nloc, unsigned& nx) {
    const unsigned G = gridDim.x * gridDim.y * gridDim.z;
    unsigned sum, cnt, mine, sp = 0u;
    for (;;) {
        sum = 0u; cnt = 0u; mine = 0u;
#pragma unroll
        for (unsigned j = 0; j < 16; ++j) { const unsigned c = xb_ld(&bar[XB_XCNT(j)]); sum += c; cnt += (c > 0u) ? 1u : 0u; mine = (j == x) ? c : mine; }
        if (sum == G) break;
        __builtin_amdgcn_s_sleep(1);
        if ((++sp & 255u) == 0u) { if (xb_ld(&bar[XB_TMO])) break; if (sp > XB_SPIN_CAP) { atomicAdd(&bar[XB_TMO], 1u); break; } }
    }
    nloc = mine > 0u ? mine : 1u; nx = cnt > 0u ? cnt : 1u;
}
__device__ __forceinline__ void xcd_barrier(const XcdBarrier& b) {
    asm volatile("s_waitcnt vmcnt(0)" ::: "memory");
    __syncthreads();
    if (threadIdx.x == 0) {
        unsigned* bar = b.bar;
        __builtin_amdgcn_s_waitcnt(0);
        asm volatile("buffer_inv sc1" ::: "memory");
        unsigned nloc = b.st[0], nx = b.st[1];
        if (nloc == 0u) { xcd_barrier_complete(bar, b.x, nloc, nx); b.st[0] = nloc; b.st[1] = nx; }
        const unsigned old = xb_add(&bar[XB_XSUB(b.x)], 1u);
        const unsigned gen = old / nloc;
        if (old + 1u == (gen + 1u) * nloc) {
            __builtin_amdgcn_fence(__ATOMIC_RELEASE, "agent");
            asm volatile("s_waitcnt vmcnt(0)" ::: "memory");
            const unsigned og = xb_add(&bar[XB_TOP], 1u);
            const unsigned tg = og / nx;
            if (og + 1u == (tg + 1u) * nx) xb_add(&bar[XB_TOPGEN], 1u);
            else XB_SPIN(xb_ld(&bar[XB_TOPGEN]) == tg, bar);
            asm volatile("" ::: "memory");
            xb_add(&bar[XB_XGEN(b.x)], 1u);
            asm volatile("s_waitcnt vmcnt(0)" ::: "memory");
        } else {
            XB_SPIN(xb_ld(&bar[XB_XGEN(b.x)]) == gen, bar);
            asm volatile("s_waitcnt vmcnt(0)" ::: "memory");
        }
    }
    __syncthreads();
}

namespace pg8 {
constexpr int BM = 256, BK = 64, HALF = 128, HTB = HALF * BK * 2, STAGE_BYTES = 8 * HTB, NXCD = 8, WGM = 8;
__host__ __device__ __forceinline__ int lds_byte(int r, int c) { const int st = (r >> 4) * 2 + (c >> 5), rr = r & 15, cc = c & 31, ob = rr * 64 + cc * 2; return st * 1024 + (ob ^ (((ob >> 9) & 1) << 5)); }
__host__ __device__ __forceinline__ void stage_rc(int b, int& R, int& C) { const int st = b / 1024, sb = b % 1024, swz = sb ^ (((sb >> 9) & 1) << 5); R = (st >> 1) * 16 + swz / 64; C = (st & 1) * 32 + (swz % 64) / 2; }
__host__ __device__ __forceinline__ int perm32(int rho) { const int n = rho >> 4, i = rho & 15; return 8 * (i >> 2) + 4 * n + (i & 3); }
struct Unit { int pm, pn; };
struct Gemm { const bf16_t* A; const bf16_t* Bt; int lda, K; size_t pairstep; };
struct StaticOrder {
    int nM, nN, nwg, G, c;
    __device__ void init(int M, int N, int G_, int c_) { nM = M / BM; nN = N / BM; nwg = nM * nN; G = G_; c = c_; }
    __device__ bool next(int i, Unit& u) const {
        const long L = (long)i * G + c; if (L >= nwg) return false;
        int wgid = (int)L; { const int q = nwg / NXCD, r = nwg % NXCD, xcd = wgid % NXCD, off = wgid / NXCD; wgid = (xcd < r ? xcd * (q + 1) : r * (q + 1) + (xcd - r) * q) + off; }
        const int nig = WGM * nN, gid = wgid / nig, fm = gid * WGM, gsz = (nM - fm) < WGM ? (nM - fm) : WGM;
        u.pm = fm + ((wgid % nig) % gsz); u.pn = (wgid % nig) / gsz; return true;
    }
};
template <class Epi, class Sched>
__device__ __forceinline__ void gemm_phase(LAS unsigned char* lds, const Gemm g, const Sched& S, const Epi& E) {
    const int tid = opaque_tid(), wid = __builtin_amdgcn_readfirstlane(tid >> 6), lane = tid & 63, wr = wid >> 2, wc = wid & 3, fr = lane & 15, fq = lane >> 4;
    const int K = g.K, nt = K / BK, lda = g.lda;
    unsigned voffA[2], voffB[2];
#pragma unroll
    for (int i = 0; i < 2; ++i) { int R, C; stage_rc(tid * 16 + i * 8192, R, C); const int Rb = Epi::PERM ? ((R & ~31) + perm32(R & 31)) : R;
        voffA[i] = (unsigned)(R * lda + C) * 2u; voffB[i] = (unsigned)(Rb * K + C) * 2u; }
    const size_t kstep = (size_t)(BK * 2);
    const size_t hstepA = (size_t)HALF * lda * 2, hstepB = (size_t)HALF * K * 2;
    const size_t tstepA = 2 * hstepA, tstepB = 2 * hstepB;
    const unsigned ldsw = (unsigned)wid * 1024u;
    const int aoff = lds_byte(wr * 64 + fr, fq * 8), boff = lds_byte(wc * 32 + fr, fq * 8);
#define PG8_SA(b, h) (((b) * 2 + (h)) * HTB)
#define PG8_SB(b, h) ((4 + (b) * 2 + (h)) * HTB)
#define PG8_STAGE(bufoff, gbase, voff) do { _Pragma("unroll") for (int _i = 0; _i < 2; ++_i) \
        __builtin_amdgcn_global_load_lds((const unsigned*)((const char*)(gbase) + (voff)[_i]), (LAS unsigned*)(lds + (bufoff) + ldsw + _i * 8192), 16, 0, 0); } while (0)
#define PG8_LDA(dst, b, h) do { _Pragma("unroll") for (int m = 0; m < 4; ++m) _Pragma("unroll") for (int k = 0; k < 2; ++k) dst[m][k] = *(const LAS bf16x8*)(lds + PG8_SA(b, h) + aoff + m * 2048 + k * 1024); } while (0)
#define PG8_LDB(dst, b, h) do { _Pragma("unroll") for (int n = 0; n < 2; ++n) _Pragma("unroll") for (int k = 0; k < 2; ++k) dst[n][k] = *(const LAS bf16x8*)(lds + PG8_SB(b, h) + boff + n * 2048 + k * 1024); } while (0)
#define PG8_MMA(ai, bj, At, Bt) do { __builtin_amdgcn_s_setprio(1); _Pragma("unroll") for (int m = 0; m < 4; ++m) _Pragma("unroll") for (int n = 0; n < 2; ++n) _Pragma("unroll") for (int k = 0; k < 2; ++k) \
        acc[ai][bj][m][n] = __builtin_amdgcn_mfma_f32_16x16x32_bf16(Bt[n][k], At[m][k], acc[ai][bj][m][n], 0, 0, 0); __builtin_amdgcn_s_setprio(0); } while (0)
#define PG8_WAIT_V(n) asm volatile("s_waitcnt vmcnt(" #n ")" ::: "memory")
#define PG8_WAIT_L(n) asm volatile("s_waitcnt lgkmcnt(" #n ")" ::: "memory")
#define PG8_BAR __builtin_amdgcn_s_barrier()
#define PG8_SCHED __builtin_amdgcn_sched_barrier(0)
    Unit cur, nxt; int ui = 0;
    if (!S.next(0, cur)) return;
    f32x4 acc[2][2][4][2];
#pragma unroll
    for (int a = 0; a < 2; ++a)
#pragma unroll
        for (int b = 0; b < 2; ++b)
#pragma unroll
            for (int m = 0; m < 4; ++m)
#pragma unroll
                for (int n = 0; n < 2; ++n) acc[a][b][m][n] = (f32x4){0.f, 0.f, 0.f, 0.f};
    bf16x8 At[4][2], B0[2][2], B1[2][2];
    const char* cA = (const char*)g.A + (size_t)cur.pm * tstepA; const char* cB = (const char*)g.Bt + (size_t)cur.pn * tstepB;
    PG8_STAGE(PG8_SB(0, 0), cB, voffB); PG8_STAGE(PG8_SA(0, 0), cA, voffA); PG8_STAGE(PG8_SB(0, 1), cB + hstepB, voffB); PG8_STAGE(PG8_SA(0, 1), cA + hstepA, voffA);
    if (wr == 1) PG8_BAR;
    PG8_WAIT_V(4); PG8_BAR;
    PG8_STAGE(PG8_SB(1, 0), cB + kstep, voffB); PG8_STAGE(PG8_SA(1, 0), cA + kstep, voffA); PG8_STAGE(PG8_SB(1, 1), cB + hstepB + kstep, voffB);
    PG8_WAIT_V(6); PG8_BAR;
    for (;;) {
        const bool has_next = S.next(ui + 1, nxt);
        const char* nA = has_next ? (const char*)g.A + (size_t)nxt.pm * tstepA : cA; const char* nB = has_next ? (const char*)g.Bt + (size_t)nxt.pn * tstepB : cB;
        for (int t = 0; t < nt; t += 2) {
            const bool last = (t == nt - 2);
            const char* a1 = cA + (size_t)(t >> 1) * g.pairstep + kstep;
            const char* a2 = last ? nA : cA + (size_t)((t >> 1) + 1) * g.pairstep; const char* b2 = last ? nB : cB + (size_t)(t + 2) * kstep;
            const char* a3 = a2 + kstep; const char* b3 = b2 + kstep;
            PG8_LDB(B0, 0, 0); PG8_SCHED; PG8_LDA(At, 0, 0); PG8_STAGE(PG8_SA(1, 1), a1 + hstepA, voffA);
            PG8_WAIT_L(8); PG8_BAR; PG8_WAIT_L(0); PG8_MMA(0, 0, At, B0); PG8_BAR; PG8_SCHED;
            PG8_LDB(B1, 0, 1); PG8_STAGE(PG8_SB(0, 0), b2, voffB);
            PG8_BAR; PG8_WAIT_L(0); PG8_MMA(0, 1, At, B1); PG8_BAR;
            PG8_LDA(At, 0, 1); PG8_STAGE(PG8_SA(0, 0), a2, voffA);
            PG8_BAR; PG8_WAIT_L(0); PG8_MMA(1, 0, At, B0); PG8_BAR; PG8_SCHED;
            PG8_STAGE(PG8_SB(0, 1), b2 + hstepB, voffB);
            PG8_WAIT_V(6); PG8_BAR; PG8_MMA(1, 1, At, B1); PG8_BAR;
            PG8_LDB(B0, 1, 0); PG8_SCHED; PG8_LDA(At, 1, 0); PG8_STAGE(PG8_SA(0, 1), a2 + hstepA, voffA);
            PG8_WAIT_L(8); PG8_BAR; PG8_WAIT_L(0); PG8_MMA(0, 0, At, B0); PG8_BAR; PG8_SCHED;
            PG8_LDB(B1, 1, 1); PG8_STAGE(PG8_SB(1, 0), b3, voffB);
            PG8_BAR; PG8_WAIT_L(0); PG8_MMA(0, 1, At, B1); PG8_BAR;
            PG8_LDA(At, 1, 1); PG8_STAGE(PG8_SA(1, 0), a3, voffA);
            PG8_BAR; PG8_WAIT_L(0); PG8_MMA(1, 0, At, B0); PG8_BAR; PG8_SCHED;
            PG8_STAGE(PG8_SB(1, 1), b3 + hstepB, voffB);
            PG8_WAIT_V(6); PG8_BAR; PG8_MMA(1, 1, At, B1); PG8_BAR;
        }
        if constexpr (!Epi::AFTER_DRAIN) E(acc, cur, wr, wc, fr, fq);
        if (!has_next) break;
#pragma unroll
        for (int a = 0; a < 2; ++a)
#pragma unroll
            for (int b = 0; b < 2; ++b)
#pragma unroll
                for (int m = 0; m < 4; ++m)
#pragma unroll
                    for (int n = 0; n < 2; ++n) acc[a][b][m][n] = (f32x4){0.f, 0.f, 0.f, 0.f};
        cur = nxt; cA = nA; cB = nB; ++ui;
    }
    PG8_WAIT_V(0);
    if (wr == 0) PG8_BAR;
    PG8_BAR;
    if constexpr (Epi::AFTER_DRAIN) E.fused(acc, cur, wr, wc, fr, fq, lds, wid, lane);
#undef PG8_SA
#undef PG8_SB
#undef PG8_STAGE
#undef PG8_LDA
#undef PG8_LDB
#undef PG8_MMA
#undef PG8_WAIT_V
#undef PG8_WAIT_L
#undef PG8_BAR
#undef PG8_SCHED
}

struct EpiInProj {
    static constexpr bool PERM = true, AFTER_DRAIN = false;
    bf16_t* Z; bf16_t* ZC; float* stats;
    template <int ACT, bool STATS = false> __device__ __forceinline__ void run(const f32x4 (&acc)[2][2][4][2], bf16_t* base, size_t ldc, size_t bjstep, int row0, int col0, float* st = nullptr, int slot = 0, int fq = 0) const {
#pragma unroll
        for (int ai = 0; ai < 2; ++ai)
#pragma unroll
            for (int m = 0; m < 4; ++m) { bf16_t* rowp = base + (size_t)(row0 + ai * HALF + m * 16) * ldc + col0; float ps = 0.f, pq = 0.f;
#pragma unroll
                for (int bj = 0; bj < 2; ++bj) { f32x4 v0 = acc[ai][bj][m][0], v1 = acc[ai][bj][m][1];
                    if (ACT == 1) {
#pragma unroll
                        for (int j = 0; j < 4; ++j) { v0[j] = act_silu(v0[j]); v1[j] = act_silu(v1[j]); } }
                    if (ACT == 2) {
#pragma unroll
                        for (int j = 0; j < 4; ++j) { v0[j] = act_gelu_tanh(v0[j]); v1[j] = act_gelu_tanh(v1[j]); } }
                    if (STATS) {
#pragma unroll
                        for (int j = 0; j < 4; ++j) { ps += v0[j] + v1[j]; pq += v0[j] * v0[j] + v1[j] * v1[j]; } }
                    u32x4 w; w.x = cvt_pk_bf16(v0[0], v0[1]); w.y = cvt_pk_bf16(v0[2], v0[3]); w.z = cvt_pk_bf16(v1[0], v1[1]); w.w = cvt_pk_bf16(v1[2], v1[3]);
                    *(u32x4*)(rowp + bj * bjstep) = w; }
                if (STATS) {
                    ps += __shfl_xor(ps, 16); ps += __shfl_xor(ps, 32); pq += __shfl_xor(pq, 16); pq += __shfl_xor(pq, 32);
                    if (fq == 0) { f32x2 o; o[0] = ps; o[1] = pq; *(f32x2*)(st + ((size_t)(row0 + ai * HALF + m * 16) * 16 + slot) * 2) = o; } } }
    }
    __device__ __forceinline__ void operator()(const f32x4 (&acc)[2][2][4][2], const Unit& u, int wr, int wc, int fr, int fq) const {
        const int cl = wc * 32 + 8 * fq;
        const int row0 = u.pm * BM + wr * 64 + fr, t = u.pn;
        if (t < 4) run<0>(acc, Z + ZSLAB(2 * t, 0), 128, ZSLAB(1, 0), row0, cl);
        else if (t < 8) run<1>(acc, Z + ZSLAB(2 * t, 0), 128, ZSLAB(1, 0), row0, cl);
        else if (t < 16) {
            bf16_t* zug = Z + ZSLAB(16 + (t - 8), 0) + cl;
#pragma unroll
            for (int ai = 0; ai < 2; ++ai)
#pragma unroll
                for (int m = 0; m < 4; ++m) { f32x4 o0, o1;
#pragma unroll
                    for (int j = 0; j < 4; ++j) { o0[j] = act_gelu_silu(acc[ai][0][m][0][j], acc[ai][1][m][0][j]); o1[j] = act_gelu_silu(acc[ai][0][m][1][j], acc[ai][1][m][1][j]); }
                    u32x4 w; w.x = cvt_pk_bf16(o0[0], o0[1]); w.y = cvt_pk_bf16(o0[2], o0[3]); w.z = cvt_pk_bf16(o1[0], o1[1]); w.w = cvt_pk_bf16(o1[2], o1[3]);
                    *(u32x4*)(zug + (size_t)(row0 + ai * HALF + m * 16) * 128) = w; }
        }
        else run<2, true>(acc, Z + ZSLAB(24 + 2 * (t - 16), 0), 128, ZSLAB(1, 0), row0, cl, stats, (t - 16) * 4 + wc, fq);
    }
};
struct EpiCtx {
    static constexpr bool PERM = true, AFTER_DRAIN = false;
    EpiInProj base;
    __device__ __forceinline__ void operator()(const f32x4 (&acc)[2][2][4][2], const Unit& u, int wr, int wc, int fr, int fq) const {
        base.template run<0>(acc, base.ZC, DM, HALF, u.pm * BM + wr * 64 + fr, u.pn * BM + wc * 32 + 8 * fq);
    }
};
struct EpiOut {
    static constexpr bool PERM = false, AFTER_DRAIN = false;
    const float* x; const float* ada; float* out; float* rowss;
    __device__ __forceinline__ void operator()(const f32x4 (&acc)[2][2][4][2], const Unit& u, int wr, int wc, int fr, int fq) const {
        const int row0 = u.pm * BM + wr * 64 + fr, col0 = u.pn * BM + wc * 32 + 4 * fq, b = u.pm >> 3;
        f32x4 gv[2][2];
#pragma unroll
        for (int bj = 0; bj < 2; ++bj)
#pragma unroll
            for (int n = 0; n < 2; ++n) gv[bj][n] = *(const f32x4*)(ada + b * 3072 + 2048 + col0 + bj * HALF + n * 16);
#pragma unroll
        for (int ai = 0; ai < 2; ++ai)
#pragma unroll
            for (int m = 0; m < 4; ++m) { const int row = row0 + ai * HALF + m * 16; const size_t off = (size_t)row * DM + col0; float ss = 0.f;
#pragma unroll
                for (int bj = 0; bj < 2; ++bj)
#pragma unroll
                    for (int n = 0; n < 2; ++n) { const f32x4 xv = *(const f32x4*)(x + off + bj * HALF + n * 16); const f32x4 o = xv + gv[bj][n] * acc[ai][bj][m][n];
                        *(f32x4*)(out + off + bj * HALF + n * 16) = o; ss += (o[0] * o[0] + o[1] * o[1]) + (o[2] * o[2] + o[3] * o[3]); }
                ss += __shfl_xor(ss, 16); ss += __shfl_xor(ss, 32);
                if (fq == 0) rowss[(size_t)row * 16 + u.pn * 4 + wc] = ss; }
    }
};
struct EpiOutFused {
    static constexpr bool PERM = false, AFTER_DRAIN = true;
    const float* x; const float* ada; const float* fg; float* out; float* xs; unsigned* cnt;
    __device__ __forceinline__ void operator()(const f32x4 (&)[2][2][4][2], const Unit&, int, int, int, int) const {}
    __device__ __forceinline__ void fused(f32x4 (&acc)[2][2][4][2], const Unit& u, int wr, int wc, int fr, int fq, LAS unsigned char* lds, int wid, int lane) const {
        LAS float* Pq = (LAS float*)lds;
        LAS float* S = (LAS float*)(lds + 4096);
        const int row0 = u.pm * BM + wr * 64 + fr, col0 = u.pn * BM + wc * 32 + 4 * fq, b = u.pm >> 3;
        f32x4 gv[2][2];
#pragma unroll
        for (int bj = 0; bj < 2; ++bj)
#pragma unroll
            for (int n = 0; n < 2; ++n) gv[bj][n] = *(const f32x4*)(ada + b * 3072 + 2048 + col0 + bj * HALF + n * 16);
#pragma unroll
        for (int ai = 0; ai < 2; ++ai)
#pragma unroll
            for (int m = 0; m < 4; ++m) { const int row = row0 + ai * HALF + m * 16; const size_t off = (size_t)row * DM + col0; float ss = 0.f;
#pragma unroll
                for (int bj = 0; bj < 2; ++bj)
#pragma unroll
                    for (int n = 0; n < 2; ++n) { const f32x4 xv = *(const f32x4*)(x + off + bj * HALF + n * 16); const f32x4 o = xv + gv[bj][n] * acc[ai][bj][m][n];
                        acc[ai][bj][m][n] = o; ss += (o[0] * o[0] + o[1] * o[1]) + (o[2] * o[2] + o[3] * o[3]); }
                ss += __shfl_xor(ss, 16); ss += __shfl_xor(ss, 32);
                if (fq == 0) Pq[(ai * HALF + wr * 64 + m * 16 + fr) * 4 + wc] = ss; }
        LDS_BARRIER();
        const int tid = wid * 64 + lane;
        if (tid < 256) { const f32x4 p = *(const LAS f32x4*)(Pq + tid * 4);
            __hip_atomic_store(xs + ((size_t)u.pm * 256 + tid) * 4 + u.pn, (p[0] + p[1]) + (p[2] + p[3]), __ATOMIC_RELAXED, __HIP_MEMORY_SCOPE_AGENT); }
        asm volatile("s_waitcnt vmcnt(0)" ::: "memory");
        if (wid < 4 && lane == 0) __hip_atomic_fetch_add(cnt + 64 * u.pm, 1u, __ATOMIC_RELAXED, __HIP_MEMORY_SCOPE_AGENT);
        if (wid == 0) { unsigned sp = 0;
            while ((unsigned)__builtin_amdgcn_readfirstlane(__hip_atomic_load(cnt + 64 * u.pm, __ATOMIC_RELAXED, __HIP_MEMORY_SCOPE_AGENT)) < 16u) { __builtin_amdgcn_s_sleep(1); if (++sp > (1u << 20)) break; }
            __builtin_amdgcn_fence(__ATOMIC_ACQUIRE, "agent");
            asm volatile("s_waitcnt vmcnt(0)" ::: "memory"); }
        LDS_BARRIER();
        if (tid < 256) { const float* sp = xs + ((size_t)u.pm * 256 + tid) * 4; float t = 0.f;
#pragma unroll
            for (int k = 0; k < 4; ++k) t += __hip_atomic_load(sp + k, __ATOMIC_RELAXED, __HIP_MEMORY_SCOPE_AGENT);
            S[tid] = 1.0f / sqrtf(t * (1.0f / DM) + 1e-6f); }
        LDS_BARRIER();
        f32x4 fgv[2][2];
#pragma unroll
        for (int bj = 0; bj < 2; ++bj)
#pragma unroll
            for (int n = 0; n < 2; ++n) fgv[bj][n] = *(const f32x4*)(fg + col0 + bj * HALF + n * 16);
#pragma unroll
        for (int ai = 0; ai < 2; ++ai)
#pragma unroll
            for (int m = 0; m < 4; ++m) { const int rl = ai * HALF + wr * 64 + m * 16 + fr; const float r = S[rl]; const size_t off = (size_t)(u.pm * BM + rl) * DM + col0;
#pragma unroll
                for (int bj = 0; bj < 2; ++bj)
#pragma unroll
                    for (int n = 0; n < 2; ++n) *(f32x4*)(out + off + bj * HALF + n * 16) = acc[ai][bj][m][n] * r * fgv[bj][n]; }
    }
};
}

__device__ __forceinline__ void p0_ada_item(LAS unsigned char* lds, const Params& P, int item) {
    const int tid = opaque_tid();
    LAS float* S = (LAS float*)lds;
    LAS float* R = (LAS float*)(lds + 40960);
    const int nn = tid & 15, kg = tid >> 4, n = item * 16 + nn;
    float w[32];
#pragma unroll
    for (int it = 0; it < 32; ++it) w[it] = P.ada_w[(size_t)(kg + 32 * it) * 3072 + n];
    for (int i = tid; i < 9 * 1024; i += NTHREADS) { const int r = i >> 10, k = i & 1023; const float v = r < 8 ? P.c[r * 1024 + k] : P.c_ctx[k]; S[i] = v / (1.0f + __expf(-v)); }
    __syncthreads();
    float acc[9];
#pragma unroll
    for (int r = 0; r < 9; ++r) acc[r] = 0.f;
#pragma unroll
    for (int it = 0; it < 32; ++it) { const int k = kg + 32 * it;
#pragma unroll
        for (int r = 0; r < 9; ++r) acc[r] += S[r * 1024 + k] * w[it]; }
#pragma unroll
    for (int r = 0; r < 9; ++r) R[(kg * 16 + nn) * 9 + r] = acc[r];
    __syncthreads();
    if (tid < 144) { const int r = tid >> 4, n2 = tid & 15; float s = 0.f;
        for (int k2 = 0; k2 < 32; ++k2) s += R[(k2 * 16 + n2) * 9 + r];
        __hip_atomic_store((float*)(P.ws + WS_ADA) + r * 3072 + item * 16 + n2, s + P.ada_b[item * 16 + n2], __ATOMIC_RELAXED, __HIP_MEMORY_SCOPE_AGENT); }
    asm volatile("s_waitcnt vmcnt(0)" ::: "memory");
    __syncthreads();
    if (tid == 0) __hip_atomic_fetch_add((unsigned*)(P.ws + WS_ADA_CNT), 1u, __ATOMIC_RELAXED, __HIP_MEMORY_SCOPE_AGENT);
}
__device__ __forceinline__ void phase0(LAS unsigned char* lds, const Params& P) {
    for (int item = blockIdx.x; item < 192; item += gridDim.x) p0_ada_item(lds, P, item);
}
__device__ __forceinline__ int win_src_col(int nd) { const int t = nd >> 8, r = nd & 255; if (t < 8) return nd; if (t < 16) { const int j = t - 8; return r < 128 ? 2048 + 128 * j + r : 4096 + 128 * j + (r - 128); } return 3072 + (nd - 4096); }
template <bool REMAP = false>
__device__ __forceinline__ void p0_transpose_item(const float* W, int K, int N, bf16_t* WT, float scale, LAS float* scr, int item, int lane) {
    const int nblk = N / 32, kb = item / nblk, nb = item % nblk, k0 = 64 * kb, n0 = 32 * nb, ns0 = REMAP ? win_src_col(n0) : n0;
    float t[32];
#pragma unroll
    for (int i = 0; i < 32; ++i) t[i] = W[(size_t)(k0 + 2 * i + (lane >> 5)) * N + ns0 + (lane & 31)];
#pragma unroll
    for (int i = 0; i < 32; ++i) scr[(2 * i + (lane >> 5)) * 33 + (lane & 31)] = t[i] * scale;
    asm volatile("s_waitcnt lgkmcnt(0)" ::: "memory");
    const int c = lane & 7;
#pragma unroll
    for (int j = 0; j < 4; ++j) { const int n = (lane >> 3) + 8 * j; const LAS float* s = scr + (8 * c) * 33 + n;
        u32x4 o; o.x = cvt_pk_bf16(s[0 * 33], s[1 * 33]); o.y = cvt_pk_bf16(s[2 * 33], s[3 * 33]); o.z = cvt_pk_bf16(s[4 * 33], s[5 * 33]); o.w = cvt_pk_bf16(s[6 * 33], s[7 * 33]);
        *(u32x4*)(WT + (size_t)(n0 + n) * K + k0 + 8 * c) = o; }
    asm volatile("s_waitcnt lgkmcnt(0)" ::: "memory");
}

__device__ __forceinline__ void phase1(LAS unsigned char* lds, const Params& P) {
    const int tid = opaque_tid(), lane = tid & 63, wid = __builtin_amdgcn_readfirstlane(tid >> 6);
    const int G = gridDim.x;
    const int gw = blockIdx.x * NWAVES + wid, NGW = G * NWAVES;
    const float* ADA = (const float*)(P.ws + WS_ADA); bf16_t* HN = (bf16_t*)(P.ws + WS_HN);
    LAS float* scr = (LAS float*)(lds + wid * 16384);
    constexpr int I_IN = (DM / 64) * (DIN / 32), I_OUT = (2 * DM / 64) * (DM / 32), I_LRU = 32 * 8;
    bf16_t* WinT = (bf16_t*)(P.ws + WS_WINT); bf16_t* WoutT = (bf16_t*)(P.ws + WS_WOUTT); bf16_t* LruW = (bf16_t*)(P.ws + WS_LRUW);
    for (int it = gw; it < I_IN + I_OUT + I_LRU; it += NGW) {
        int r = it;
        if (r < I_IN) { p0_transpose_item<true>(P.w_in, DM, DIN, WinT, 1.0f, scr, r, lane); continue; } r -= I_IN;
        if (r < I_OUT) { p0_transpose_item(P.w_out, 2 * DM, DM, WoutT, 1.0f, scr, r, lane); continue; } r -= I_OUT;
        { const int mat = r >> 3, sub = r & 7, dir = mat >> 4, gate = (mat >> 3) & 1, h = mat & 7;
          const float* src = (gate ? P.lru_wx : P.lru_wa) + (size_t)(dir * 8 + h) * 16384;
          p0_transpose_item(src, 128, 128, LruW + (size_t)((dir * 2 + gate) * 8 + h) * 16384, -LOG2E, scr, sub, lane); }
    }
    bf16_t* SguW = (bf16_t*)(P.ws + WS_SGUW);
    for (int i = (blockIdx.x * NTHREADS + tid) * 4; i < 8 * 128 * 128; i += G * NTHREADS * 4) {
        const f32x4 v = *(const f32x4*)(P.sgu_w + i); u32x2 o; o.x = cvt_pk_bf16(v[0], v[1]); o.y = cvt_pk_bf16(v[2], v[3]); *(u32x2*)(SguW + i) = o; }
    if (wid == 0) { unsigned sp = 0;
        while ((unsigned)__builtin_amdgcn_readfirstlane(__hip_atomic_load((unsigned*)(P.ws + WS_ADA_CNT), __ATOMIC_RELAXED, __HIP_MEMORY_SCOPE_AGENT)) < 192u) { __builtin_amdgcn_s_sleep(1); if (++sp > (1u << 20)) break; }
        __builtin_amdgcn_fence(__ATOMIC_ACQUIRE, "agent");
        asm volatile("s_waitcnt vmcnt(0)" ::: "memory"); }
    __syncthreads();
    f32x4 ng[4];
#pragma unroll
    for (int j = 0; j < 4; ++j) ng[j] = *(const f32x4*)(P.norm_g + 4 * (lane + 64 * j));
    const int per = (MROWS + CROWS + NGW - 1) / NGW;
    for (int r0 = gw * per; r0 < (gw + 1) * per && r0 < MROWS + CROWS; r0 += 3) {
        f32x4 v[3][4], sh[3][4], sc[3][4];
#pragma unroll
        for (int u = 0; u < 3; ++u) { const int row = r0 + u < MROWS + CROWS ? r0 + u : MROWS + CROWS - 1;
            const float* src = row < MROWS ? P.x + (size_t)row * DM : P.ctx + (size_t)(row - MROWS) * DM;
            const int bi = row < MROWS ? row / SEQ : 8;
#pragma unroll
            for (int j = 0; j < 4; ++j) { v[u][j] = ((const f32x4*)src)[lane + 64 * j]; sh[u][j] = *(const f32x4*)(ADA + bi * 3072 + 4 * (lane + 64 * j)); sc[u][j] = *(const f32x4*)(ADA + bi * 3072 + 1024 + 4 * (lane + 64 * j)); } }
#pragma unroll
        for (int u = 0; u < 3; ++u) { const int row = r0 + u;
            float s = 0.f;
#pragma unroll
            for (int j = 0; j < 4; ++j) s += (v[u][j][0] * v[u][j][0] + v[u][j][1] * v[u][j][1]) + (v[u][j][2] * v[u][j][2] + v[u][j][3] * v[u][j][3]);
            const float rstd = 1.0f / sqrtf(wave_sum(s) * (1.0f / DM) + 1e-6f);
            if (row < (gw + 1) * per && row < MROWS + CROWS) {
                u32x2* o8 = (u32x2*)(HN + (size_t)row * DM) + lane;
#pragma unroll
                for (int j = 0; j < 4; ++j) { const f32x4 o = v[u][j] * rstd * ng[j] * (sc[u][j] + 1.0f) + sh[u][j];
                    u32x2 w; w.x = cvt_pk_bf16(o[0], o[1]); w.y = cvt_pk_bf16(o[2], o[3]); o8[64 * j] = w; } } }
    }
}

constexpr int XC_PITCH = 272;
struct LruTile { const bf16_t* src; int ld, L, t0; };
__device__ __forceinline__ LruTile lru_tile(const bf16_t* Z, const bf16_t* ZC, int b, int h, int dir, int sc) {
    LruTile t;
    if (sc == 0) { t.src = ZC + (size_t)b * CTXL * DM + h * 128; t.ld = DM; t.L = CTXL; t.t0 = 0; }
    else { const int chunk = dir == 0 ? sc - 1 : 8 - sc; t.src = Z + ZSLAB(h, (size_t)b * SEQ); t.ld = 128; t.L = SEQ; t.t0 = chunk * 256; }
    return t;
}
__device__ __forceinline__ void lru_load_rows(u32x4 (&rows)[11], const LruTile& T, int tr, int cgp) {
    const unsigned loff = (unsigned)(tr * 8 * T.ld + cgp * 8);
#pragma unroll
    for (int j = 0; j < 11; ++j) { const bf16_t* bj = T.src + (long)(T.t0 - 1 + j) * T.ld; rows[j] = *(const u32x4*)(bj + loff); }
}
constexpr int LRU_IO_OFF = 256 * XC_PITCH + 2048 + 64 * XC_PITCH + 2560;
constexpr int IO_NP = 80, IO_WP = 144;
template <int dir>
__device__ __forceinline__ void lru_pass(LAS unsigned char* lds, const Params& P, int b, int h, int q, bool dry) {
    const int tid = opaque_tid(), lane = tid & 63, wid = __builtin_amdgcn_readfirstlane(tid >> 6), g = lane >> 5, nl = lane & 31;
    const int chl = q * 32 + nl, ch = h * 128 + chl;
    LAS unsigned char* XC = lds;
    LAS float* AGG = (LAS float*)(lds + 256 * XC_PITCH);
    LAS unsigned char* WB = lds + 256 * XC_PITCH + 2048;
    LAS float* CWL = (LAS float*)(lds + 256 * XC_PITCH + 2048 + 64 * XC_PITCH);
    LAS unsigned char* TIN = lds + LRU_IO_OFF;
    LAS unsigned char* TOUT = lds + LRU_IO_OFF + 256 * (dir == 0 ? IO_NP : IO_WP);
    bf16_t* Z = (bf16_t*)(P.ws + WS_Z); const bf16_t* ZC = (const bf16_t*)(P.ws + WS_ZC); unsigned* HFW = (unsigned*)(P.ws + WS_HF);
    const bf16_t* LruW = (const bf16_t*)(P.ws + WS_LRUW);
    const int cgp = tid & 15, tr = tid >> 4;
    const int s_i = 16 * ((nl >> 2) & 1) + ((nl >> 3) << 2) + (nl & 3);
    const bf16_t* Zg = Z + ZSLAB(8 + h, (size_t)b * SEQ) + q * 32;
    unsigned* Hg = HFW + (size_t)b * SEQ * DM + h * 128 + q * 32;
    {
#pragma unroll
        for (int i = 0; i < 2; ++i) { const int idx = tid + i * NTHREADS, gate = idx >> 9, n = (idx >> 4) & 31, kc = idx & 15;
            *(LAS u32x4*)(WB + (gate * 32 + n) * XC_PITCH + kc * 16) = *(const u32x4*)(LruW + ((size_t)((dir * 2 + gate) * 8 + h) * 128 + q * 32 + n) * 128 + kc * 8); }
        const float br = -LOG2E * P.lru_ba[(dir * 8 + h) * 128 + chl], bi = -LOG2E * P.lru_bx[(dir * 8 + h) * 128 + chl];
        const float lam = P.lru_lambda[dir * 1024 + ch];
        const float cl = -8.0f * LOG2E * log1pf(__expf(-lam));
        const float icl = 1.0f / cl;
        float carry = 0.f;
        LruTile cur = lru_tile(Z, ZC, b, h, dir, 0);
        u32x4 rows[11];
        constexpr int NIN = dir == 0 ? 2 : 4;
        u32x4 inr[NIN];
        lru_load_rows(rows, cur, tr, cgp);
#pragma unroll
        for (int i = 0; i < NIN; ++i) inr[i] = (u32x4){0u, 0u, 0u, 0u};
        int t0_prev = 0;
        for (int sc = 0; sc < 9; ++sc) {
            const bool isctx = (sc == 0);
            const int t0 = cur.t0;
#pragma unroll
            for (int j = 0; j < 11; ++j) { if (j != 0 && j < 9) continue;
                const int t = t0 + tr * 8 - 1 + j; if (t < 0 || t >= cur.L) rows[j] = (u32x4){0u, 0u, 0u, 0u}; }
            f32x2 cw2[4][4], cb2[4];
#pragma unroll
            for (int k = 0; k < 5; ++k) { const f32x4 a = *(const LAS f32x4*)(CWL + k * 128 + cgp * 8), c2 = *(const LAS f32x4*)(CWL + k * 128 + cgp * 8 + 4);
                if (k < 4) { cw2[k][0] = (f32x2){a[0], a[1]}; cw2[k][1] = (f32x2){a[2], a[3]}; cw2[k][2] = (f32x2){c2[0], c2[1]}; cw2[k][3] = (f32x2){c2[2], c2[3]}; }
                else { cb2[0] = (f32x2){a[0], a[1]}; cb2[1] = (f32x2){a[2], a[3]}; cb2[2] = (f32x2){c2[0], c2[1]}; cb2[3] = (f32x2){c2[2], c2[3]}; } }
#pragma unroll
            for (int j = 0; j < 8; ++j) {
                f32x2 o0 = cb2[0], o1 = cb2[1], o2 = cb2[2], o3 = cb2[3];
#pragma unroll
                for (int k = 0; k < 4; ++k) { const u32x4 rr = rows[j + k];
                    o0 = cw2[k][0] * (f32x2){bf_lo(rr.x), bf_hi(rr.x)} + o0; o1 = cw2[k][1] * (f32x2){bf_lo(rr.y), bf_hi(rr.y)} + o1;
                    o2 = cw2[k][2] * (f32x2){bf_lo(rr.z), bf_hi(rr.z)} + o2; o3 = cw2[k][3] * (f32x2){bf_lo(rr.w), bf_hi(rr.w)} + o3; }
                u32x4 w; w.x = cvt_pk_bf16(o0[0], o0[1]); w.y = cvt_pk_bf16(o1[0], o1[1]); w.z = cvt_pk_bf16(o2[0], o2[1]); w.w = cvt_pk_bf16(o3[0], o3[1]);
                *(LAS u32x4*)(XC + (tr * 8 + j) * XC_PITCH + cgp * 16) = w;
            }
#pragma unroll
            for (int i = 0; i < NIN; ++i) { const int id = tid + i * NTHREADS;
                if (dir == 0) *(LAS u32x4*)(TIN + (id >> 2) * IO_NP + (id & 3) * 16) = inr[i];
                else *(LAS u32x4*)(TIN + (id >> 3) * IO_WP + (id & 7) * 16) = inr[i]; }
            LruTile nxt = cur;
            if (sc < 8) { nxt = lru_tile(Z, ZC, b, h, dir, sc + 1); lru_load_rows(rows, nxt, tr, cgp);
#pragma unroll
                for (int i = 0; i < NIN; ++i) { const int id = tid + i * NTHREADS;
                    if (dir == 0) inr[i] = *(const u32x4*)(Zg + (size_t)(nxt.t0 + (id >> 2)) * 128 + (id & 3) * 8);
                    else inr[i] = *(const u32x4*)(Hg + (size_t)(nxt.t0 + (id >> 3)) * DM + (id & 7) * 4); } }
            LDS_BARRIER();
            if (sc >= 2) {
                if (dir == 0) {
#pragma unroll
                    for (int i = 0; i < 4; ++i) { const int id = tid + i * NTHREADS; *(u32x4*)(Hg + (size_t)(t0_prev + (id >> 3)) * DM + (id & 7) * 4) = *(const LAS u32x4*)(TOUT + (id >> 3) * IO_WP + (id & 7) * 16); }
                } else if (!dry) {
#pragma unroll
                    for (int i = 0; i < 2; ++i) { const int id = tid + i * NTHREADS; *(u32x4*)(Z + ZSLAB(8 + h, (size_t)b * SEQ + t0_prev + (id >> 2)) + q * 32 + (id & 3) * 8) = *(const LAS u32x4*)(TOUT + (id >> 2) * IO_NP + (id & 3) * 16); }
                }
            }
            f32x16 zr, zi;
#pragma unroll
            for (int v = 0; v < 16; ++v) { zr[v] = br; zi[v] = bi; }
            const int sbase = 32 * wid + 16 * g;
            { const int sl = 32 * wid + s_i; const int tlA = dir == 0 ? sl : 255 - sl;
              const LAS unsigned char* ap = XC + tlA * XC_PITCH + 16 * g;
              const LAS unsigned char* wrp = WB + nl * XC_PITCH + 16 * g; const LAS unsigned char* wip = wrp + 32 * XC_PITCH;
#pragma unroll
              for (int ks = 0; ks < 8; ++ks) { const bf16x8 A = *(const LAS bf16x8*)(ap + 32 * ks);
                  const bf16x8 Br = *(const LAS bf16x8*)(wrp + 32 * ks), Bi = *(const LAS bf16x8*)(wip + 32 * ks);
                  zr = __builtin_amdgcn_mfma_f32_32x32x16_bf16(A, Br, zr, 0, 0, 0); zi = __builtin_amdgcn_mfma_f32_32x32x16_bf16(A, Bi, zi, 0, 0, 0); } }
            unsigned xcb[16], pk[16];
#pragma unroll
            for (int v = 0; v < 16; ++v) { const int s = sbase + v; const int tl = dir == 0 ? s : 255 - s; xcb[v] = *(const LAS bf16_t*)(XC + tl * XC_PITCH + chl * 2);
                if (dir == 0) pk[v] = *(const LAS bf16_t*)(TIN + tl * IO_NP + nl * 2); else pk[v] = *(const LAS unsigned*)(TIN + tl * IO_WP + nl * 4); }
            float Pp = 1.f, E = 0.f;
#pragma unroll
            for (int v = 0; v < 16; ++v) {
                const float xcv = __uint_as_float(xcb[v] << 16);
                const float l2a = __builtin_amdgcn_rcpf(fmaf(__builtin_amdgcn_exp2f(zr[v]), icl, icl));
                const float ig = __builtin_amdgcn_rcpf(1.0f + __builtin_amdgcn_exp2f(zi[v]));
                const float a = __builtin_amdgcn_exp2f(l2a);
                const float sq = __builtin_amdgcn_sqrtf(fmaf(-a, a, 1.0f));
                const float u = sq * ig * xcv;
                E = fmaf(a, E, u); Pp *= a; zr[v] = E; zi[v] = Pp; }
            const float Po = __shfl_xor(Pp, 32), Eo = __shfl_xor(E, 32);
            const float P0 = g ? Po : Pp, E0 = g ? Eo : E, P1 = g ? Pp : Po, E1 = g ? E : Eo;
            if (g == 0) { AGG[(wid * 2 + 0) * 32 + nl] = P0 * P1; AGG[(wid * 2 + 1) * 32 + nl] = fmaf(P1, E0, E1); }
            LDS_BARRIER();
            float cin = carry, cend = carry;
#pragma unroll
            for (int w = 0; w < 8; ++w) { const float pw = AGG[(w * 2 + 0) * 32 + nl], ew = AGG[(w * 2 + 1) * 32 + nl]; if (w == wid) cin = cend; cend = fmaf(pw, cend, ew); }
            carry = cend;
            if (g) cin = fmaf(P0, cin, E0);
            if (!isctx) {
#pragma unroll
                for (int v = 0; v < 16; ++v) { const float hv = fmaf(zi[v], cin, zr[v]);
                    const int s = sbase + v; const int tl = dir == 0 ? s : 255 - s;
                    if (dir == 0) *(LAS unsigned*)(TOUT + tl * IO_WP + nl * 4) = (cvt_pk_bf16(hv, 0.f) & 0xffffu) | (pk[v] << 16);
                    else *(LAS bf16_t*)(TOUT + tl * IO_NP + nl * 2) = f2bf((bf_lo(pk[v]) + hv) * bf_hi(pk[v])); }
            }
            t0_prev = t0;
            cur = nxt;
        }
        LDS_BARRIER();
        if (dir == 0) {
#pragma unroll
            for (int i = 0; i < 4; ++i) { const int id = tid + i * NTHREADS; *(u32x4*)(Hg + (size_t)(t0_prev + (id >> 3)) * DM + (id & 7) * 4) = *(const LAS u32x4*)(TOUT + (id >> 3) * IO_WP + (id & 7) * 16); }
        } else if (!dry) {
#pragma unroll
            for (int i = 0; i < 2; ++i) { const int id = tid + i * NTHREADS; *(u32x4*)(Z + ZSLAB(8 + h, (size_t)b * SEQ + t0_prev + (id >> 2)) + q * 32 + (id & 3) * 8) = *(const LAS u32x4*)(TOUT + (id >> 2) * IO_NP + (id & 3) * 16); }
        }
    }
}
__device__ __forceinline__ void lru_strip(LAS unsigned char* lds, const Params& P, int strip, bool dry) {
    const int tid = opaque_tid();
    const int b = strip >> 5, h = (strip >> 2) & 7, q = strip & 3;
    LAS float* CWL = (LAS float*)(lds + 256 * XC_PITCH + 2048 + 64 * XC_PITCH);
    for (int i = tid; i < 640; i += NTHREADS) { const int k = i >> 7, c = i & 127; CWL[i] = k < 4 ? P.conv_w[k * 1024 + h * 128 + c] : P.conv_b[h * 128 + c]; }
    LDS_BARRIER();
    lru_pass<0>(lds, P, b, h, q, dry);
    asm volatile("s_waitcnt vmcnt(0)" ::: "memory"); __syncthreads();
    if (tid < 64) { __builtin_amdgcn_fence(__ATOMIC_ACQUIRE, "agent"); asm volatile("s_waitcnt vmcnt(0)" ::: "memory"); }
    __syncthreads();
    lru_pass<1>(lds, P, b, h, q, dry);
    __syncthreads();
}

constexpr int VT_PITCH = 272;
struct SguRegs { unsigned vw[16]; u32x4 uu[4]; float lg0, lg1, lb0, lb1; };
__device__ __forceinline__ void sgu_load(SguRegs& R, const Params& P, const bf16_t* Z, size_t R0, int gg, int tid) {
    const int cp = tid & 63, tg = tid >> 6, c0 = 2 * cp;
#pragma unroll
    for (int half = 0; half < 2; ++half)
#pragma unroll
        for (int j = 0; j < 8; ++j) R.vw[half * 8 + j] = *(const unsigned*)(Z + ZSLAB(24 + gg, R0 + half * 64 + tg * 8 + j) + c0);
    const int rr = tid >> 4, cc = (tid & 15) * 8;
#pragma unroll
    for (int i = 0; i < 4; ++i) { const bf16_t* zp = Z + ZSLAB(16 + gg, R0 + rr + 32 * i) + cc; R.uu[i] = *(const u32x4*)zp; }
    R.lg0 = P.sgu_ln_g[gg * 128 + c0]; R.lg1 = P.sgu_ln_g[gg * 128 + c0 + 1]; R.lb0 = P.sgu_ln_b[gg * 128 + c0]; R.lb1 = P.sgu_ln_b[gg * 128 + c0 + 1];
}
__device__ __forceinline__ unsigned mul_pk_bf16(unsigned a, unsigned b) { return cvt_pk_bf16(bf_lo(a) * bf_lo(b), bf_hi(a) * bf_hi(b)); }
__device__ __forceinline__ void sgu_item(LAS unsigned char* lds, const Params& P, int item, bool dry) {
    const int tid = opaque_tid(), lane = tid & 63, wid = __builtin_amdgcn_readfirstlane(tid >> 6);
    const int b = item >> 5, chunk = (item >> 1) & 15, gh = item & 1;
    const size_t R0 = (size_t)b * SEQ + chunk * 128;
    LAS unsigned char* VT = lds;
    LAS unsigned char* UG = lds + 128 * VT_PITCH;
    LAS float* ST = (LAS float*)(lds + 2 * 128 * VT_PITCH);
    bf16_t* Z = (bf16_t*)(P.ws + WS_Z); const bf16_t* SguW = (const bf16_t*)(P.ws + WS_SGUW);
    SguRegs R;
    sgu_load(R, P, Z, R0, gh * 4, tid);
    if (tid < 128) { const f32x4* sp = (const f32x4*)((const float*)(P.ws + WS_STATS) + (R0 + tid) * 32); float s = 0.f, ss = 0.f;
#pragma unroll
        for (int k = 0; k < 8; ++k) { const f32x4 v = sp[k]; s += v[0] + v[2]; ss += v[1] + v[3]; }
        const float mean = s * (1.0f / 1024.0f), var = fmaxf(ss * (1.0f / 1024.0f) - mean * mean, 0.f);
        ST[tid * 2] = mean; ST[tid * 2 + 1] = 1.0f / sqrtf(var + 1e-5f); }
    LDS_BARRIER();
    const int cp = tid & 63, tg = tid >> 6, c0 = 2 * cp;
    const int rr = tid >> 4, cc = (tid & 15) * 8;
    const int pb = wid & 3, cb0 = (wid >> 2) * 2, ml = lane & 31, kh = lane >> 5;
    for (int gi = 0; gi < 4; ++gi) {
        const int gg = gh * 4 + gi;
#pragma unroll
        for (int half = 0; half < 2; ++half) { const int tb = half * 64 + tg * 8;
            float v0[8], v1[8];
#pragma unroll
            for (int j = 0; j < 8; ++j) { const float mean = ST[(tb + j) * 2], rs = ST[(tb + j) * 2 + 1]; const unsigned w = R.vw[half * 8 + j];
                v0[j] = (bf_lo(w) - mean) * rs * R.lg0 + R.lb0; v1[j] = (bf_hi(w) - mean) * rs * R.lg1 + R.lb1; }
            u32x4 o0, o1;
            o0.x = cvt_pk_bf16(v0[0], v0[1]); o0.y = cvt_pk_bf16(v0[2], v0[3]); o0.z = cvt_pk_bf16(v0[4], v0[5]); o0.w = cvt_pk_bf16(v0[6], v0[7]);
            o1.x = cvt_pk_bf16(v1[0], v1[1]); o1.y = cvt_pk_bf16(v1[2], v1[3]); o1.z = cvt_pk_bf16(v1[4], v1[5]); o1.w = cvt_pk_bf16(v1[6], v1[7]);
            *(LAS u32x4*)(VT + c0 * VT_PITCH + tb * 2) = o0; *(LAS u32x4*)(VT + (c0 + 1) * VT_PITCH + tb * 2) = o1; }
#pragma unroll
        for (int i = 0; i < 4; ++i) { const u32x4 w = R.uu[i];
            *(LAS u32x4*)(UG + (rr + 32 * i) * VT_PITCH + cc * 2) = w; }
        if (gi < 3) sgu_load(R, P, Z, R0, gg + 1, tid);
        LDS_BARRIER();
        bf16x8 Aw[8];
        { const bf16_t* ap = SguW + ((size_t)gg * 128 + pb * 32 + ml) * 128 + 8 * kh;
#pragma unroll
          for (int ks = 0; ks < 8; ++ks) Aw[ks] = *(const bf16x8*)(ap + 16 * ks); }
        float bsv[16];
#pragma unroll
        for (int v = 0; v < 16; ++v) bsv[v] = P.sgu_b[gg * 128 + pb * 32 + (v & 3) + 8 * (v >> 2) + 4 * kh];
#pragma unroll
        for (int cbi = 0; cbi < 2; ++cbi) { const int ccol = (cb0 + cbi) * 32 + ml;
            f32x16 acc;
#pragma unroll
            for (int v = 0; v < 16; ++v) acc[v] = 0.f;
            const LAS unsigned char* bp = VT + ccol * VT_PITCH + 16 * kh;
#pragma unroll
            for (int ks = 0; ks < 8; ++ks) { const bf16x8 Bf = *(const LAS bf16x8*)(bp + 32 * ks); acc = __builtin_amdgcn_mfma_f32_32x32x16_bf16(Aw[ks], Bf, acc, 0, 0, 0); }
#pragma unroll
            for (int v = 0; v < 16; ++v) { const int p = pb * 32 + (v & 3) + 8 * (v >> 2) + 4 * kh;
                LAS bf16_t* up = (LAS bf16_t*)(UG + p * VT_PITCH + ccol * 2);
                *up = f2bf(bf2f(*up) * (acc[v] + bsv[v])); } }
        LDS_BARRIER();
        if (!dry) {
#pragma unroll
            for (int i = 0; i < 4; ++i) *(u32x4*)(Z + ZSLAB(16 + gg, R0 + rr + 32 * i) + cc) = *(const LAS u32x4*)(UG + (rr + 32 * i) * VT_PITCH + cc * 2); }
    }
    LDS_BARRIER();
}

__device__ __forceinline__ void sgu_list(LAS unsigned char* lds, const Params& P, int i0, int istride) {
    const int tid = opaque_tid(), lane = tid & 63, wid = __builtin_amdgcn_readfirstlane(tid >> 6);
    if (i0 >= 1024) return;
    LAS unsigned char* VT = lds;
    LAS unsigned char* UG = lds + 128 * VT_PITCH;
    LAS float* ST = (LAS float*)(lds + 2 * 128 * VT_PITCH);
    bf16_t* Z = (bf16_t*)(P.ws + WS_Z); const bf16_t* SguW = (const bf16_t*)(P.ws + WS_SGUW);
    SguRegs R;
    sgu_load(R, P, Z, (size_t)(i0 >> 7) * SEQ + ((i0 >> 3) & 15) * 128, i0 & 7, tid);
    const int cp = tid & 63, tg = tid >> 6, c0 = 2 * cp;
    const int rr = tid >> 4, cc = (tid & 15) * 8;
    const int pb = wid & 3, cb0 = (wid >> 2) * 2, ml = lane & 31, kh = lane >> 5;
    for (int i = i0; i < 1024; i += istride) {
        const int gg = i & 7; const size_t R0 = (size_t)(i >> 7) * SEQ + ((i >> 3) & 15) * 128;
        if (tid < 128) { const f32x4* sp = (const f32x4*)((const float*)(P.ws + WS_STATS) + (R0 + tid) * 32); float s1 = 0.f, ss = 0.f;
#pragma unroll
            for (int k = 0; k < 8; ++k) { const f32x4 v = sp[k]; s1 += v[0] + v[2]; ss += v[1] + v[3]; }
            const float mean = s1 * (1.0f / 1024.0f), var = fmaxf(ss * (1.0f / 1024.0f) - mean * mean, 0.f);
            ST[tid * 2] = mean; ST[tid * 2 + 1] = 1.0f / sqrtf(var + 1e-5f); }
        LDS_BARRIER();
#pragma unroll
        for (int half = 0; half < 2; ++half) { const int tb = half * 64 + tg * 8;
            float v0[8], v1[8];
#pragma unroll
            for (int j = 0; j < 8; ++j) { const float mean = ST[(tb + j) * 2], rs = ST[(tb + j) * 2 + 1]; const unsigned w = R.vw[half * 8 + j];
                v0[j] = (bf_lo(w) - mean) * rs * R.lg0 + R.lb0; v1[j] = (bf_hi(w) - mean) * rs * R.lg1 + R.lb1; }
            u32x4 o0, o1;
            o0.x = cvt_pk_bf16(v0[0], v0[1]); o0.y = cvt_pk_bf16(v0[2], v0[3]); o0.z = cvt_pk_bf16(v0[4], v0[5]); o0.w = cvt_pk_bf16(v0[6], v0[7]);
            o1.x = cvt_pk_bf16(v1[0], v1[1]); o1.y = cvt_pk_bf16(v1[2], v1[3]); o1.z = cvt_pk_bf16(v1[4], v1[5]); o1.w = cvt_pk_bf16(v1[6], v1[7]);
            *(LAS u32x4*)(VT + c0 * VT_PITCH + tb * 2) = o0; *(LAS u32x4*)(VT + (c0 + 1) * VT_PITCH + tb * 2) = o1; }
#pragma unroll
        for (int k = 0; k < 4; ++k) *(LAS u32x4*)(UG + (rr + 32 * k) * VT_PITCH + cc * 2) = R.uu[k];
        { const int inx = i + istride; if (inx < 1024) sgu_load(R, P, Z, (size_t)(inx >> 7) * SEQ + ((inx >> 3) & 15) * 128, inx & 7, tid); }
        LDS_BARRIER();
        bf16x8 Aw[8];
        { const bf16_t* ap = SguW + ((size_t)gg * 128 + pb * 32 + ml) * 128 + 8 * kh;
#pragma unroll
          for (int ks = 0; ks < 8; ++ks) Aw[ks] = *(const bf16x8*)(ap + 16 * ks); }
        float bsv[16];
#pragma unroll
        for (int v = 0; v < 16; ++v) bsv[v] = P.sgu_b[gg * 128 + pb * 32 + (v & 3) + 8 * (v >> 2) + 4 * kh];
#pragma unroll
        for (int cbi = 0; cbi < 2; ++cbi) { const int ccol = (cb0 + cbi) * 32 + ml;
            f32x16 acc;
#pragma unroll
            for (int v = 0; v < 16; ++v) acc[v] = 0.f;
            const LAS unsigned char* bp = VT + ccol * VT_PITCH + 16 * kh;
#pragma unroll
            for (int ks = 0; ks < 8; ++ks) { const bf16x8 Bf = *(const LAS bf16x8*)(bp + 32 * ks); acc = __builtin_amdgcn_mfma_f32_32x32x16_bf16(Aw[ks], Bf, acc, 0, 0, 0); }
#pragma unroll
            for (int v = 0; v < 16; ++v) { const int p = pb * 32 + (v & 3) + 8 * (v >> 2) + 4 * kh;
                LAS bf16_t* up = (LAS bf16_t*)(UG + p * VT_PITCH + ccol * 2);
                *up = f2bf(bf2f(*up) * (acc[v] + bsv[v])); } }
        LDS_BARRIER();
#pragma unroll
        for (int k = 0; k < 4; ++k) *(u32x4*)(Z + ZSLAB(16 + gg, R0 + rr + 32 * k) + cc) = *(const LAS u32x4*)(UG + (rr + 32 * k) * VT_PITCH + cc * 2);
    }
    LDS_BARRIER();
}

__device__ __forceinline__ void phase5(const Params& P) {
    const int tid = opaque_tid(), lane = tid & 63, wid = tid >> 6;
    const int gw = blockIdx.x * NWAVES + wid, NGW = gridDim.x * NWAVES;
    const float* RS = (const float*)(P.ws + WS_ROWSS);
    for (int row = gw; row < MROWS; row += NGW) {
        f32x4* xr = (f32x4*)(P.out + (size_t)row * DM) + lane;
        f32x4 v[4];
#pragma unroll
        for (int j = 0; j < 4; ++j) v[j] = xr[64 * j];
        float ss = RS[(size_t)row * 16 + (lane & 15)];
        ss += __shfl_xor(ss, 1); ss += __shfl_xor(ss, 2); ss += __shfl_xor(ss, 4); ss += __shfl_xor(ss, 8);
        const float rstd = 1.0f / sqrtf(ss * (1.0f / DM) + 1e-6f);
#pragma unroll
        for (int j = 0; j < 4; ++j) { const f32x4 fg = *(const f32x4*)(P.final_g + 4 * (lane + 64 * j)); xr[64 * j] = v[j] * rstd * fg; }
    }
}

constexpr int LDS_BYTES = 155648;
static_assert(LRU_IO_OFF + 256 * (IO_NP + IO_WP) <= LDS_BYTES - 16, "LRU LDS map");
__global__ void __launch_bounds__(NTHREADS, 2) fwd_megakernel(Params P) {
    extern __shared__ __attribute__((aligned(16))) unsigned char smem[];
    LAS unsigned char* lds = (LAS unsigned char*)smem;
    cg::grid_group grid = cg::this_grid();
    const int lo = P.ph_lo, hi = P.ph_hi;
    volatile LAS unsigned* bst = (volatile LAS unsigned*)(lds + LDS_BYTES - 16);
    if (threadIdx.x < 2) bst[threadIdx.x] = 0u;
    __syncthreads();
    XcdBarrier xbar = xcd_barrier_post((unsigned*)(P.ws + WS_BAR), bst);
    if (lo > 1000) grid.sync();
#define IN(k) (lo <= (k) && (k) < hi)
#define SEAM(k) do { if (IN(k) && IN((k) + 1)) xcd_barrier(xbar); } while (0)
    if (IN(0)) for (int r = 0; r < P.rep0; ++r) { phase0(lds, P); __syncthreads(); }
    if (IN(1)) for (int r = 0; r < P.rep1; ++r) { phase1(lds, P); __syncthreads(); }
    SEAM(1);
    if (IN(2)) for (int r = 0; r < P.rep2; ++r) {
        pg8::Gemm g{(const bf16_t*)(P.ws + WS_HN), (const bf16_t*)(P.ws + WS_WINT), DM, DM, 256};
        pg8::StaticOrder S; S.init(MROWS, DIN, (int)gridDim.x, (int)blockIdx.x);
        pg8::EpiInProj E{(bf16_t*)(P.ws + WS_Z), (bf16_t*)(P.ws + WS_ZC), (float*)(P.ws + WS_STATS)};
        pg8::gemm_phase<pg8::EpiInProj, pg8::StaticOrder>(lds, g, S, E);
    }
    SEAM(2);
    if (IN(3)) {
        const int G = (int)gridDim.x, bx = (int)blockIdx.x, ctxB = G < 32 ? G : 32;
        if (bx < ctxB) {
            pg8::Gemm g{(const bf16_t*)(P.ws + WS_HN) + (size_t)MROWS * DM, (const bf16_t*)(P.ws + WS_WINT), DM, DM, 256};
            pg8::StaticOrder S; S.init(CROWS, DM, ctxB, bx);
            pg8::EpiCtx EC{pg8::EpiInProj{(bf16_t*)(P.ws + WS_Z), (bf16_t*)(P.ws + WS_ZC), (float*)(P.ws + WS_STATS)}};
            pg8::gemm_phase<pg8::EpiCtx, pg8::StaticOrder>(lds, g, S, EC);
            __syncthreads();
            if (threadIdx.x == 0) { __builtin_amdgcn_fence(__ATOMIC_RELEASE, "agent"); asm volatile("s_waitcnt vmcnt(0)" ::: "memory");
                __hip_atomic_fetch_add((unsigned*)(P.ws + WS_CTX_CNT), 1u, __ATOMIC_RELAXED, __HIP_MEMORY_SCOPE_AGENT); }
            if (G <= ctxB) sgu_list(lds, P, bx, G);
        } else sgu_list(lds, P, bx - ctxB, G - ctxB);
        __syncthreads();
        if (threadIdx.x < 64) { unsigned sp = 0;
            while ((unsigned)__builtin_amdgcn_readfirstlane(__hip_atomic_load((unsigned*)(P.ws + WS_CTX_CNT), __ATOMIC_RELAXED, __HIP_MEMORY_SCOPE_AGENT)) < (unsigned)ctxB) { __builtin_amdgcn_s_sleep(1); if (++sp > (1u << 20)) break; }
            __builtin_amdgcn_fence(__ATOMIC_ACQUIRE, "agent");
            asm volatile("s_waitcnt vmcnt(0)" ::: "memory"); }
        __syncthreads();
        for (int s2 = bx; s2 < 256; s2 += G) { lru_strip(lds, P, ((s2 & 7) << 5) | (s2 >> 3), false); __syncthreads(); }
    }
    SEAM(3);
    const bool fuse_norm = (gridDim.x == 256);
    if (IN(4)) {
        pg8::Gemm g{(const bf16_t*)(P.ws + WS_Z) + ZSLAB(8, 0), (const bf16_t*)(P.ws + WS_WOUTT), 128, 2 * DM, ZSLAB(1, 0) * 2};
        pg8::StaticOrder S; S.init(MROWS, DM, (int)gridDim.x, (int)blockIdx.x);
        if (fuse_norm) {
            pg8::EpiOutFused E{P.x, (const float*)(P.ws + WS_ADA), P.final_g, P.out, (float*)(P.ws + WS_ROWSS), (unsigned*)(P.ws + WS_BAR + 16384)};
            pg8::gemm_phase<pg8::EpiOutFused, pg8::StaticOrder>(lds, g, S, E);
        } else {
            pg8::EpiOut E{P.x, (const float*)(P.ws + WS_ADA), P.out, (float*)(P.ws + WS_ROWSS)};
            pg8::gemm_phase<pg8::EpiOut, pg8::StaticOrder>(lds, g, S, E);
        }
    }
    if (!fuse_norm) {
        SEAM(4);
        if (IN(5)) phase5(P);
    }
#undef IN
#undef SEAM
}

#define PROBE_REP0 1
#define PROBE_REP1 1
#define PROBE_REP2 1
#define PROBE_REP3A 1
#define PROBE_REP3B 1
#define PROBE_REP4 1
#ifndef MK_N_LAUNCHES
#define MK_N_LAUNCHES 1
#endif

extern "C" void kernel_launch(void* const* d_in, const int* in_sizes, int n_in, void* d_out, int out_size, void* d_ws, size_t ws_size, hipStream_t stream) {
    static int grid = 0;
    if (grid == 0) {
        if (n_in != 21 || out_size != MROWS * DM || ws_size < WS_END) { fprintf(stderr, "kernel_launch: unexpected shapes (n_in %d out %d ws %zu)\n", n_in, out_size, ws_size); grid = -1; return; }
        int dev = 0, cus = 0, per_cu = 0;
        hipGetDevice(&dev);
        hipDeviceGetAttribute(&cus, hipDeviceAttributeMultiprocessorCount, dev);
        if (hipFuncSetAttribute((const void*)fwd_megakernel, hipFuncAttributeMaxDynamicSharedMemorySize, LDS_BYTES) != hipSuccess) { fprintf(stderr, "kernel_launch: hipFuncSetAttribute failed\n"); grid = -1; return; }
        if (hipOccupancyMaxActiveBlocksPerMultiprocessor(&per_cu, (const void*)fwd_megakernel, NTHREADS, LDS_BYTES) != hipSuccess || per_cu < 1) { fprintf(stderr, "kernel_launch: occupancy query failed (%d)\n", per_cu); (void)hipGetLastError(); grid = -1; return; }
        grid = cus;
    }
    if (grid < 0) return;
    Params p{};
    const float** f = (const float**)&p;
    for (int i = 0; i < 21; ++i) f[i] = (const float*)d_in[i];
    p.out = (float*)d_out; p.ws = (unsigned char*)d_ws;
    p.rep0 = PROBE_REP0; p.rep1 = PROBE_REP1; p.rep2 = PROBE_REP2; p.rep3a = PROBE_REP3A; p.rep3b = PROBE_REP3B; p.rep4 = PROBE_REP4;
    if (hipMemsetAsync((char*)d_ws + WS_BAR, 0, WS_BAR_BYTES, stream) != hipSuccess) { fprintf(stderr, "kernel_launch: memset failed\n"); return; }
#if MK_N_LAUNCHES == 1
    p.ph_lo = 0; p.ph_hi = 6;
    void* args[] = {&p};
    hipError_t e = hipLaunchCooperativeKernel((void*)fwd_megakernel, dim3(grid), dim3(NTHREADS), args, LDS_BYTES, stream);
    if (e != hipSuccess) fprintf(stderr, "kernel_launch: cooperative launch failed: %s (grid %d)\n", hipGetErrorString(e), grid);
#else
    for (int ph = 0; ph < 6; ++ph) { p.ph_lo = ph; p.ph_hi = ph + 1; hipLaunchKernelGGL(fwd_megakernel, dim3(grid), dim3(NTHREADS), LDS_BYTES, stream, p); }
#endif
}
```

```cpp
#include <hip/hip_runtime.h>
#include <hip/hip_cooperative_groups.h>
#include <cstdio>
namespace cg = cooperative_groups;

#define LAS __attribute__((address_space(3)))
typedef unsigned short bf16_t;
typedef short bf16x8 __attribute__((ext_vector_type(8)));
typedef float f32x4 __attribute__((ext_vector_type(4)));
typedef float f32x16 __attribute__((ext_vector_type(16)));
typedef unsigned u32x4 __attribute__((ext_vector_type(4)));
typedef unsigned u32x2 __attribute__((ext_vector_type(2)));
typedef float f32x2 __attribute__((ext_vector_type(2)));

constexpr int NB = 8, SEQ = 2048, DM = 1024, CTXL = 256, DIN = 5120;
constexpr int MROWS = NB * SEQ;
constexpr int CROWS = NB * CTXL;
constexpr int NTHREADS = 512, NWAVES = 8;
#define ZSLAB(slab, row) (((size_t)(slab) * MROWS + (size_t)(row)) * 128)
constexpr float LOG2E = 1.4426950408889634f;

constexpr size_t MiB = 1u << 20;
constexpr size_t WS_ADA = 0;
constexpr size_t WS_BAR = 512 * 1024;
constexpr size_t WS_ADA_CNT = WS_BAR + 32768;
constexpr size_t WS_CTX_CNT = WS_BAR + 32768 + 128;
constexpr size_t WS_BAR_BYTES = 32768 + 256;
constexpr size_t WS_ROWSS = 1 * MiB;
constexpr size_t WS_WINT = 2 * MiB;
constexpr size_t WS_WOUTT = 12 * MiB;
constexpr size_t WS_LRUW = 16 * MiB;
constexpr size_t WS_SGUW = 17 * MiB;
constexpr size_t WS_HN = 20 * MiB;
constexpr size_t WS_HF = 20 * MiB;
constexpr size_t WS_Z = 84 * MiB;
constexpr size_t WS_ZC = 244 * MiB;
constexpr size_t WS_STATS = 248 * MiB;
constexpr size_t WS_END = 250 * MiB;

struct Params {
    const float *x, *c, *ctx, *c_ctx, *ada_w, *ada_b, *norm_g, *w_in, *conv_w, *conv_b, *lru_wa, *lru_ba, *lru_wx, *lru_bx, *lru_lambda,
        *sgu_ln_g, *sgu_ln_b, *sgu_w, *sgu_b, *w_out, *final_g;
    float* out; unsigned char* ws;
    int ph_lo, ph_hi;
    int rep0, rep1, rep2, rep3a, rep3b, rep4;
};

__device__ __forceinline__ unsigned cvt_pk_bf16(float lo, float hi) { unsigned r; asm volatile("v_cvt_pk_bf16_f32 %0, %1, %2" : "=v"(r) : "v"(lo), "v"(hi)); return r; }
__device__ __forceinline__ float bf_lo(unsigned u) { return __uint_as_float(u << 16); }
__device__ __forceinline__ float bf_hi(unsigned u) { return __uint_as_float(u & 0xffff0000u); }
__device__ __forceinline__ float bf2f(bf16_t h) { return __uint_as_float(((unsigned)h) << 16); }
__device__ __forceinline__ bf16_t f2bf(float f) { return (bf16_t)(cvt_pk_bf16(f, 0.f) & 0xffffu); }
__device__ __forceinline__ float wave_sum(float v) {
#pragma unroll
    for (int o = 1; o < 64; o <<= 1) v += __shfl_xor(v, o);
    return v;
}
__device__ __forceinline__ int opaque_tid() { int t = threadIdx.x; asm volatile("" : "+v"(t)); return t; }
#define LDS_BARRIER() do { asm volatile("s_waitcnt lgkmcnt(0)" ::: "memory"); __builtin_amdgcn_s_barrier(); asm volatile("" ::: "memory"); } while (0)
__device__ __forceinline__ float fast_sigmoid(float v) { return __builtin_amdgcn_rcpf(1.0f + __builtin_amdgcn_exp2f(-LOG2E * v)); }
__device__ __forceinline__ float act_silu(float v) { return v * fast_sigmoid(v); }
__device__ __forceinline__ float act_gelu_tanh(float v) {
    constexpr float c1 = -2.0f * LOG2E * 0.7978845608028654f, c2 = c1 * 0.044715f;
    const float t = v * v, p = fmaf(t, c2, c1);
    return v * __builtin_amdgcn_rcpf(1.0f + __builtin_amdgcn_exp2f(v * p));
}
__device__ __forceinline__ float act_gelu_silu(float u, float g) {
    constexpr float c1 = -2.0f * LOG2E * 0.7978845608028654f, c2 = c1 * 0.044715f;
    const float eu = __builtin_amdgcn_exp2f(u * fmaf(u * u, c2, c1)), eg = __builtin_amdgcn_exp2f(g * (-LOG2E));
    return (u * g) * __builtin_amdgcn_rcpf((1.0f + eu) * (1.0f + eg));
}
#define XB_TMO      128
#define XB_XCNT(j)  (256  + 64 * (j))
#define XB_XSUB(j)  (1280 + 64 * (j))
#define XB_XGEN(j)  (2304 + 64 * (j))
#define XB_TOP      3328
#define XB_TOPGEN   3392
#define XCD_BAR_WORDS 3456
#define XB_SPIN_CAP (1u << 18)
__device__ __forceinline__ unsigned xb_ld(unsigned* p)              { return __hip_atomic_load(p, __ATOMIC_RELAXED, __HIP_MEMORY_SCOPE_AGENT); }
__device__ __forceinline__ unsigned xb_add(unsigned* p, unsigned v) { return __hip_atomic_fetch_add(p, v, __ATOMIC_RELAXED, __HIP_MEMORY_SCOPE_AGENT); }
__device__ __forceinline__ unsigned xb_xcc_id() { return (unsigned)__builtin_amdgcn_s_getreg((3 << 11) | 20) & 0xFu; }
#define XB_SPIN(cond, bar) do { unsigned _sp = 0; while (cond) { __builtin_amdgcn_s_sleep(1); \
    if ((++_sp & 255u) == 0u) { if (xb_ld(&(bar)[XB_TMO])) break; if (_sp > XB_SPIN_CAP) { atomicAdd(&(bar)[XB_TMO], 1u); break; } } } } while (0)
struct XcdBarrier { unsigned* bar; unsigned x; volatile LAS unsigned* st; };
__device__ __forceinline__ XcdBarrier xcd_barrier_post(unsigned* bar, volatile LAS unsigned* st) {
    XcdBarrier b; b.bar = bar; b.x = xb_xcc_id(); b.st = st;
    if (threadIdx.x == 0) (void)xb_add(&bar[XB_XCNT(b.x)], 1u);
    return b;
}
__device__ __forceinline__ void xcd_barrier_complete(unsigned* bar, unsigned x, unsigned& nloc, unsigned& nx) {
    const unsigned G = gridDim.x * gridDim.y * gridDim.z;
    unsigned sum, cnt, mine, sp = 0u;
    for (;;) {
        sum = 0u; cnt = 0u; mine = 0u;
#pragma unroll
        for (unsigned j = 0; j < 16; ++j) { const unsigned c = xb_ld(&bar[XB_XCNT(j)]); sum += c; cnt += (c > 0u) ? 1u : 0u; mine = (j == x) ? c : mine; }
        if (sum == G) break;
        __builtin_amdgcn_s_sleep(1);
        if ((++sp & 255u) == 0u) { if (xb_ld(&bar[XB_TMO])) break; if (sp > XB_SPIN_CAP) { atomicAdd(&bar[XB_TMO], 1u); break; } }
    }
    nloc = mine > 0u ? mine : 1u; nx = cnt > 0u ? cnt : 1u;
}
__device__ __forceinline__ void xcd_barrier(const XcdBarrier& b) {
    asm volatile("s_waitcnt vmcnt(0)" ::: "memory");
    __syncthreads();
    if (threadIdx.x == 0) {
        unsigned* bar = b.bar;
        __builtin_amdgcn_s_waitcnt(0);
        asm volatile("buffer_inv sc1" ::: "memory");
        unsigned nloc = b.st[0], nx = b.st[1];
        if (nloc == 0u) { xcd_barrier_complete(bar, b.x, nloc, nx); b.st[0] = nloc; b.st[1] = nx; }
        const unsigned old = xb_add(&bar[XB_XSUB(b.x)], 1u);
        const unsigned gen = old / nloc;
        if (old + 1u == (gen + 1u) * nloc) {
            __builtin_amdgcn_fence(__ATOMIC_RELEASE, "agent");
            asm volatile("s_waitcnt vmcnt(0)" ::: "memory");
            const unsigned og = xb_add(&bar[XB_TOP], 1u);
            const unsigned tg = og / nx;
            if (og + 1u == (tg + 1u) * nx) xb_add(&bar[XB_TOPGEN], 1u);
            else XB_SPIN(xb_ld(&bar[XB_TOPGEN]) == tg, bar);
            asm volatile("" ::: "memory");
            xb_add(&bar[XB_XGEN(b.x)], 1u);
            asm volatile("s_waitcnt vmcnt(0)" ::: "memory");
        } else {
            XB_SPIN(xb_ld(&bar[XB_XGEN(b.x)]) == gen, bar);
            asm volatile("s_waitcnt vmcnt(0)" ::: "memory");
        }
    }
    __syncthreads();
}

namespace pg8 {
constexpr int BM = 256, BK = 64, HALF = 128, HTB = HALF * BK * 2, STAGE_BYTES = 8 * HTB, NXCD = 8, WGM = 8;
__host__ __device__ __forceinline__ int lds_byte(int r, int c) { const int st = (r >> 4) * 2 + (c >> 5), rr = r & 15, cc = c & 31, ob = rr * 64 + cc * 2; return st * 1024 + (ob ^ (((ob >> 9) & 1) << 5)); }
__host__ __device__ __forceinline__ void stage_rc(int b, int& R, int& C) { const int st = b / 1024, sb = b % 1024, swz = sb ^ (((sb >> 9) & 1) << 5); R = (st >> 1) * 16 + swz / 64; C = (st & 1) * 32 + (swz % 64) / 2; }
__host__ __device__ __forceinline__ int perm32(int rho) { const int n = rho >> 4, i = rho & 15; return 8 * (i >> 2) + 4 * n + (i & 3); }
struct Unit { int pm, pn; };
struct Gemm { const bf16_t* A; const bf16_t* Bt; int lda, K; size_t pairstep; };
struct StaticOrder {
    int nM, nN, nwg, G, c;
    __device__ void init(int M, int N, int G_, int c_) { nM = M / BM; nN = N / BM; nwg = nM * nN; G = G_; c = c_; }
    __device__ bool next(int i, Unit& u) const {
        const long L = (long)i * G + c; if (L >= nwg) return false;
        int wgid = (int)L; { const int q = nwg / NXCD, r = nwg % NXCD, xcd = wgid % NXCD, off = wgid / NXCD; wgid = (xcd < r ? xcd * (q + 1) : r * (q + 1) + (xcd - r) * q) + off; }
        const int nig = WGM * nN, gid = wgid / nig, fm = gid * WGM, gsz = (nM - fm) < WGM ? (nM - fm) : WGM;
        u.pm = fm + ((wgid % nig) % gsz); u.pn = (wgid % nig) / gsz; return true;
    }
};
template <class Epi, class Sched>
__device__ __forceinline__ void gemm_phase(LAS unsigned char* lds, const Gemm g, const Sched& S, const Epi& E) {
    const int tid = opaque_tid(), wid = __builtin_amdgcn_readfirstlane(tid >> 6), lane = tid & 63, wr = wid >> 2, wc = wid & 3, fr = lane & 15, fq = lane >> 4;
    const int K = g.K, nt = K / BK, lda = g.lda;
    unsigned voffA[2], voffB[2];
#pragma unroll
    for (int i = 0; i < 2; ++i) { int R, C; stage_rc(tid * 16 + i * 8192, R, C); const int Rb = Epi::PERM ? ((R & ~31) + perm32(R & 31)) : R;
        voffA[i] = (unsigned)(R * lda + C) * 2u; voffB[i] = (unsigned)(Rb * K + C) * 2u; }
    const size_t kstep = (size_t)(BK * 2);
    const size_t hstepA = (size_t)HALF * lda * 2, hstepB = (size_t)HALF * K * 2;
    const size_t tstepA = 2 * hstepA, tstepB = 2 * hstepB;
    const unsigned ldsw = (unsigned)wid * 1024u;
    const int aoff = lds_byte(wr * 64 + fr, fq * 8), boff = lds_byte(wc * 32 + fr, fq * 8);
#define PG8_SA(b, h) (((b) * 2 + (h)) * HTB)
#define PG8_SB(b, h) ((4 + (b) * 2 + (h)) * HTB)
#define PG8_STAGE(bufoff, gbase, voff) do { _Pragma("unroll") for (int _i = 0; _i < 2; ++_i) \
        __builtin_amdgcn_global_load_lds((const unsigned*)((const char*)(gbase) + (voff)[_i]), (LAS unsigned*)(lds + (bufoff) + ldsw + _i * 8192), 16, 0, 0); } while (0)
#define PG8_LDA(dst, b, h) do { _Pragma("unroll") for (int m = 0; m < 4; ++m) _Pragma("unroll") for (int k = 0; k < 2; ++k) dst[m][k] = *(const LAS bf16x8*)(lds + PG8_SA(b, h) + aoff + m * 2048 + k * 1024); } while (0)
#define PG8_LDB(dst, b, h) do { _Pragma("unroll") for (int n = 0; n < 2; ++n) _Pragma("unroll") for (int k = 0; k < 2; ++k) dst[n][k] = *(const LAS bf16x8*)(lds + PG8_SB(b, h) + boff + n * 2048 + k * 1024); } while (0)
#define PG8_MMA(ai, bj, At, Bt) do { __builtin_amdgcn_s_setprio(1); _Pragma("unroll") for (int m = 0; m < 4; ++m) _Pragma("unroll") for (int n = 0; n < 2; ++n) _Pragma("unroll") for (int k = 0; k < 2; ++k) \
        acc[ai][bj][m][n] = __builtin_amdgcn_mfma_f32_16x16x32_bf16(Bt[n][k], At[m][k], acc[ai][bj][m][n], 0, 0, 0); __builtin_amdgcn_s_setprio(0); } while (0)
#define PG8_WAIT_V(n) asm volatile("s_waitcnt vmcnt(" #n ")" ::: "memory")
#define PG8_WAIT_L(n) asm volatile("s_waitcnt lgkmcnt(" #n ")" ::: "memory")
#define PG8_BAR __builtin_amdgcn_s_barrier()
#define PG8_SCHED __builtin_amdgcn_sched_barrier(0)
    Unit cur, nxt; int ui = 0;
    if (!S.next(0, cur)) return;
    f32x4 acc[2][2][4][2];
#pragma unroll
    for (int a = 0; a < 2; ++a)
#pragma unroll
        for (int b = 0; b < 2; ++b)
#pragma unroll
            for (int m = 0; m < 4; ++m)
#pragma unroll
                for (int n = 0; n < 2; ++n) acc[a][b][m][n] = (f32x4){0.f, 0.f, 0.f, 0.f};
    bf16x8 At[4][2], B0[2][2], B1[2][2];
    const char* cA = (const char*)g.A + (size_t)cur.pm * tstepA; const char* cB = (const char*)g.Bt + (size_t)cur.pn * tstepB;
    PG8_STAGE(PG8_SB(0, 0), cB, voffB); PG8_STAGE(PG8_SA(0, 0), cA, voffA); PG8_STAGE(PG8_SB(0, 1), cB + hstepB, voffB); PG8_STAGE(PG8_SA(0, 1), cA + hstepA, voffA);
    if (wr == 1) PG8_BAR;
    PG8_WAIT_V(4); PG8_BAR;
    PG8_STAGE(PG8_SB(1, 0), cB + kstep, voffB); PG8_STAGE(PG8_SA(1, 0), cA + kstep, voffA); PG8_STAGE(PG8_SB(1, 1), cB + hstepB + kstep, voffB);
    PG8_WAIT_V(6); PG8_BAR;
    for (;;) {
        const bool has_next = S.next(ui + 1, nxt);
        const char* nA = has_next ? (const char*)g.A + (size_t)nxt.pm * tstepA : cA; const char* nB = has_next ? (const char*)g.Bt + (size_t)nxt.pn * tstepB : cB;
        for (int t = 0; t < nt; t += 2) {
            const bool last = (t == nt - 2);
            const char* a1 = cA + (size_t)(t >> 1) * g.pairstep + kstep;
            const char* a2 = last ? nA : cA + (size_t)((t >> 1) + 1) * g.pairstep; const char* b2 = last ? nB : cB + (size_t)(t + 2) * kstep;
            const char* a3 = a2 + kstep; const char* b3 = b2 + kstep;
            PG8_LDB(B0, 0, 0); PG8_SCHED; PG8_LDA(At, 0, 0); PG8_STAGE(PG8_SA(1, 1), a1 + hstepA, voffA);
            PG8_WAIT_L(8); PG8_BAR; PG8_WAIT_L(0); PG8_MMA(0, 0, At, B0); PG8_BAR; PG8_SCHED;
            PG8_LDB(B1, 0, 1); PG8_STAGE(PG8_SB(0, 0), b2, voffB);
            PG8_BAR; PG8_WAIT_L(0); PG8_MMA(0, 1, At, B1); PG8_BAR;
            PG8_LDA(At, 0, 1); PG8_STAGE(PG8_SA(0, 0), a2, voffA);
            PG8_BAR; PG8_WAIT_L(0); PG8_MMA(1, 0, At, B0); PG8_BAR; PG8_SCHED;
            PG8_STAGE(PG8_SB(0, 1), b2 + hstepB, voffB);
            PG8_WAIT_V(6); PG8_BAR; PG8_MMA(1, 1, At, B1); PG8_BAR;
            PG8_LDB(B0, 1, 0); PG8_SCHED; PG8_LDA(At, 1, 0); PG8_STAGE(PG8_SA(0, 1), a2 + hstepA, voffA);
            PG8_WAIT_L(8); PG8_BAR; PG8_WAIT_L(0); PG8_MMA(0, 0, At, B0); PG8_BAR; PG8_SCHED;
            PG8_LDB(B1, 1, 1); PG8_STAGE(PG8_SB(1, 0), b3, voffB);
            PG8_BAR; PG8_WAIT_L(0); PG8_MMA(0, 1, At, B1); PG8_BAR;
            PG8_LDA(At, 1, 1); PG8_STAGE(PG8_SA(1, 0), a3, voffA);
            PG8_BAR; PG8_WAIT_L(0); PG8_MMA(1, 0, At, B0); PG8_BAR; PG8_SCHED;
            PG8_STAGE(PG8_SB(1, 1), b3 + hstepB, voffB);
            PG8_WAIT_V(6); PG8_BAR; PG8_MMA(1, 1, At, B1); PG8_BAR;
        }
        if constexpr (!Epi::AFTER_DRAIN) E(acc, cur, wr, wc, fr, fq);
        if (!has_next) break;
#pragma unroll
        for (int a = 0; a < 2; ++a)
#pragma unroll
            for (int b = 0; b < 2; ++b)
#pragma unroll
                for (int m = 0; m < 4; ++m)
#pragma unroll
                    for (int n = 0; n < 2; ++n) acc[a][b][m][n] = (f32x4){0.f, 0.f, 0.f, 0.f};
        cur = nxt; cA = nA; cB = nB; ++ui;
    }
    PG8_WAIT_V(0);
    if (wr == 0) PG8_BAR;
    PG8_BAR;
    if constexpr (Epi::AFTER_DRAIN) E.fused(acc, cur, wr, wc, fr, fq, lds, wid, lane);
#undef PG8_SA
#undef PG8_SB
#undef PG8_STAGE
#undef PG8_LDA
#undef PG8_LDB
#undef PG8_MMA
#undef PG8_WAIT_V
#undef PG8_WAIT_L
#undef PG8_BAR
#undef PG8_SCHED
}

struct EpiInProj {
    static constexpr bool PERM = true, AFTER_DRAIN = false;
    bf16_t* Z; bf16_t* ZC; float* stats;
    template <int ACT, bool STATS = false> __device__ __forceinline__ void run(const f32x4 (&acc)[2][2][4][2], bf16_t* base, size_t ldc, size_t bjstep, int row0, int col0, float* st = nullptr, int slot = 0, int fq = 0) const {
#pragma unroll
        for (int ai = 0; ai < 2; ++ai)
#pragma unroll
            for (int m = 0; m < 4; ++m) { bf16_t* rowp = base + (size_t)(row0 + ai * HALF + m * 16) * ldc + col0; float ps = 0.f, pq = 0.f;
#pragma unroll
                for (int bj = 0; bj < 2; ++bj) { f32x4 v0 = acc[ai][bj][m][0], v1 = acc[ai][bj][m][1];
                    if (ACT == 1) {
#pragma unroll
                        for (int j = 0; j < 4; ++j) { v0[j] = act_silu(v0[j]); v1[j] = act_silu(v1[j]); } }
                    if (ACT == 2) {
#pragma unroll
                        for (int j = 0; j < 4; ++j) { v0[j] = act_gelu_tanh(v0[j]); v1[j] = act_gelu_tanh(v1[j]); } }
                    if (STATS) {
#pragma unroll
                        for (int j = 0; j < 4; ++j) { ps += v0[j] + v1[j]; pq += v0[j] * v0[j] + v1[j] * v1[j]; } }
                    u32x4 w; w.x = cvt_pk_bf16(v0[0], v0[1]); w.y = cvt_pk_bf16(v0[2], v0[3]); w.z = cvt_pk_bf16(v1[0], v1[1]); w.w = cvt_pk_bf16(v1[2], v1[3]);
                    *(u32x4*)(rowp + bj * bjstep) = w; }
                if (STATS) {
                    ps += __shfl_xor(ps, 16); ps += __shfl_xor(ps, 32); pq += __shfl_xor(pq, 16); pq += __shfl_xor(pq, 32);
                    if (fq == 0) { f32x2 o; o[0] = ps; o[1] = pq; *(f32x2*)(st + ((size_t)(row0 + ai * HALF + m * 16) * 16 + slot) * 2) = o; } } }
    }
    __device__ __forceinline__ void operator()(const f32x4 (&acc)[2][2][4][2], const Unit& u, int wr, int wc, int fr, int fq) const {
        const int cl = wc * 32 + 8 * fq;
        const int row0 = u.pm * BM + wr * 64 + fr, t = u.pn;
        if (t < 4) run<0>(acc, Z + ZSLAB(2 * t, 0), 128, ZSLAB(1, 0), row0, cl);
        else if (t < 8) run<1>(acc, Z + ZSLAB(2 * t, 0), 128, ZSLAB(1, 0), row0, cl);
        else if (t < 16) {
            bf16_t* zug = Z + ZSLAB(16 + (t - 8), 0) + cl;
#pragma unroll
            for (int ai = 0; ai < 2; ++ai)
#pragma unroll
                for (int m = 0; m < 4; ++m) { f32x4 o0, o1;
#pragma unroll
                    for (int j = 0; j < 4; ++j) { o0[j] = act_gelu_silu(acc[ai][0][m][0][j], acc[ai][1][m][0][j]); o1[j] = act_gelu_silu(acc[ai][0][m][1][j], acc[ai][1][m][1][j]); }
                    u32x4 w; w.x = cvt_pk_bf16(o0[0], o0[1]); w.y = cvt_pk_bf16(o0[2], o0[3]); w.z = cvt_pk_bf16(o1[0], o1[1]); w.w = cvt_pk_bf16(o1[2], o1[3]);
                    *(u32x4*)(zug + (size_t)(row0 + ai * HALF + m * 16) * 128) = w; }
        }
        else run<2, true>(acc, Z + ZSLAB(24 + 2 * (t - 16), 0), 128, ZSLAB(1, 0), row0, cl, stats, (t - 16) * 4 + wc, fq);
    }
};
struct EpiCtx {
    static constexpr bool PERM = true, AFTER_DRAIN = false;
    EpiInProj base;
    __device__ __forceinline__ void operator()(const f32x4 (&acc)[2][2][4][2], const Unit& u, int wr, int wc, int fr, int fq) const {
        const int row0 = u.pm * BM + wr * 64 + fr, col0 = u.pn * BM + wc * 32 + 8 * fq;
#pragma unroll
        for (int ai = 0; ai < 2; ++ai)
#pragma unroll
            for (int m = 0; m < 4; ++m)
#pragma unroll
                for (int bj = 0; bj < 2; ++bj) { const f32x4 v0 = acc[ai][bj][m][0], v1 = acc[ai][bj][m][1];
                    u32x4 w; w.x = cvt_pk_bf16(v0[0], v0[1]); w.y = cvt_pk_bf16(v0[2], v0[3]); w.z = cvt_pk_bf16(v1[0], v1[1]); w.w = cvt_pk_bf16(v1[2], v1[3]);
                    bf16_t* dst = base.ZC + (size_t)(row0 + ai * HALF + m * 16) * DM + col0 + bj * HALF;
                    asm volatile("global_store_dwordx4 %0, %1, off sc1" :: "v"(dst), "v"(w) : "memory"); }
    }
};
struct EpiOut {
    static constexpr bool PERM = false, AFTER_DRAIN = false;
    const float* x; const float* ada; float* out; float* rowss;
    __device__ __forceinline__ void operator()(const f32x4 (&acc)[2][2][4][2], const Unit& u, int wr, int wc, int fr, int fq) const {
        const int row0 = u.pm * BM + wr * 64 + fr, col0 = u.pn * BM + wc * 32 + 4 * fq, b = u.pm >> 3;
        f32x4 gv[2][2];
#pragma unroll
        for (int bj = 0; bj < 2; ++bj)
#pragma unroll
            for (int n = 0; n < 2; ++n) gv[bj][n] = *(const f32x4*)(ada + b * 3072 + 2048 + col0 + bj * HALF + n * 16);
#pragma unroll
        for (int ai = 0; ai < 2; ++ai)
#pragma unroll
            for (int m = 0; m < 4; ++m) { const int row = row0 + ai * HALF + m * 16; const size_t off = (size_t)row * DM + col0; float ss = 0.f;
#pragma unroll
                for (int bj = 0; bj < 2; ++bj)
#pragma unroll
                    for (int n = 0; n < 2; ++n) { const f32x4 xv = *(const f32x4*)(x + off + bj * HALF + n * 16); const f32x4 o = xv + gv[bj][n] * acc[ai][bj][m][n];
                        *(f32x4*)(out + off + bj * HALF + n * 16) = o; ss += (o[0] * o[0] + o[1] * o[1]) + (o[2] * o[2] + o[3] * o[3]); }
                ss += __shfl_xor(ss, 16); ss += __shfl_xor(ss, 32);
                if (fq == 0) rowss[(size_t)row * 16 + u.pn * 4 + wc] = ss; }
    }
};
struct EpiOutFused {
    static constexpr bool PERM = false, AFTER_DRAIN = true;
    const float* x; const float* ada; const float* fg; float* out; float* xs; unsigned* cnt;
    __device__ __forceinline__ void operator()(const f32x4 (&)[2][2][4][2], const Unit&, int, int, int, int) const {}
    __device__ __forceinline__ void fused(f32x4 (&acc)[2][2][4][2], const Unit& u, int wr, int wc, int fr, int fq, LAS unsigned char* lds, int wid, int lane) const {
        LAS float* Pq = (LAS float*)lds;
        LAS float* S = (LAS float*)(lds + 4096);
        const int row0 = u.pm * BM + wr * 64 + fr, col0 = u.pn * BM + wc * 32 + 4 * fq, b = u.pm >> 3;
        f32x4 gv[2][2];
#pragma unroll
        for (int bj = 0; bj < 2; ++bj)
#pragma unroll
            for (int n = 0; n < 2; ++n) gv[bj][n] = *(const f32x4*)(ada + b * 3072 + 2048 + col0 + bj * HALF + n * 16);
#pragma unroll
        for (int ai = 0; ai < 2; ++ai)
#pragma unroll
            for (int m = 0; m < 4; ++m) { const int row = row0 + ai * HALF + m * 16; const size_t off = (size_t)row * DM + col0; float ss = 0.f;
#pragma unroll
                for (int bj = 0; bj < 2; ++bj)
#pragma unroll
                    for (int n = 0; n < 2; ++n) { const f32x4 xv = *(const f32x4*)(x + off + bj * HALF + n * 16); const f32x4 o = xv + gv[bj][n] * acc[ai][bj][m][n];
                        acc[ai][bj][m][n] = o; ss += (o[0] * o[0] + o[1] * o[1]) + (o[2] * o[2] + o[3] * o[3]); }
                ss += __shfl_xor(ss, 16); ss += __shfl_xor(ss, 32);
                if (fq == 0) Pq[(ai * HALF + wr * 64 + m * 16 + fr) * 4 + wc] = ss; }
        LDS_BARRIER();
        const int tid = wid * 64 + lane;
        if (tid < 256) { const f32x4 p = *(const LAS f32x4*)(Pq + tid * 4);
            __hip_atomic_store(xs + ((size_t)u.pm * 256 + tid) * 4 + u.pn, (p[0] + p[1]) + (p[2] + p[3]), __ATOMIC_RELAXED, __HIP_MEMORY_SCOPE_AGENT); }
        asm volatile("s_waitcnt vmcnt(0)" ::: "memory");
        if (wid < 4 && lane == 0) __hip_atomic_fetch_add(cnt + 64 * u.pm, 1u, __ATOMIC_RELAXED, __HIP_MEMORY_SCOPE_AGENT);
        if (wid == 0) { unsigned sp = 0;
            while ((unsigned)__builtin_amdgcn_readfirstlane(__hip_atomic_load(cnt + 64 * u.pm, __ATOMIC_RELAXED, __HIP_MEMORY_SCOPE_AGENT)) < 16u) { __builtin_amdgcn_s_sleep(1); if (++sp > (1u << 20)) break; }
            __builtin_amdgcn_fence(__ATOMIC_ACQUIRE, "agent");
            asm volatile("s_waitcnt vmcnt(0)" ::: "memory"); }
        LDS_BARRIER();
        if (tid < 256) { const float* sp = xs + ((size_t)u.pm * 256 + tid) * 4; float t = 0.f;
#pragma unroll
            for (int k = 0; k < 4; ++k) t += __hip_atomic_load(sp + k, __ATOMIC_RELAXED, __HIP_MEMORY_SCOPE_AGENT);
            S[tid] = 1.0f / sqrtf(t * (1.0f / DM) + 1e-6f); }
        LDS_BARRIER();
        f32x4 fgv[2][2];
#pragma unroll
        for (int bj = 0; bj < 2; ++bj)
#pragma unroll
            for (int n = 0; n < 2; ++n) fgv[bj][n] = *(const f32x4*)(fg + col0 + bj * HALF + n * 16);
#pragma unroll
        for (int ai = 0; ai < 2; ++ai)
#pragma unroll
            for (int m = 0; m < 4; ++m) { const int rl = ai * HALF + wr * 64 + m * 16 + fr; const float r = S[rl]; const size_t off = (size_t)(u.pm * BM + rl) * DM + col0;
#pragma unroll
                for (int bj = 0; bj < 2; ++bj)
#pragma unroll
                    for (int n = 0; n < 2; ++n) *(f32x4*)(out + off + bj * HALF + n * 16) = acc[ai][bj][m][n] * r * fgv[bj][n]; }
    }
};
}

__device__ __forceinline__ void p0_ada_item(LAS unsigned char* lds, const Params& P, int item) {
    const int tid = opaque_tid();
    LAS float* S = (LAS float*)lds;
    LAS float* R = (LAS float*)(lds + 40960);
    const int nn = tid & 15, kg = tid >> 4, n = item * 16 + nn;
    float w[32];
#pragma unroll
    for (int it = 0; it < 32; ++it) w[it] = P.ada_w[(size_t)(kg + 32 * it) * 3072 + n];
    for (int i = tid; i < 9 * 1024; i += NTHREADS) { const int r = i >> 10, k = i & 1023; const float v = r < 8 ? P.c[r * 1024 + k] : P.c_ctx[k]; S[i] = v / (1.0f + __expf(-v)); }
    __syncthreads();
    float acc[9];
#pragma unroll
    for (int r = 0; r < 9; ++r) acc[r] = 0.f;
#pragma unroll
    for (int it = 0; it < 32; ++it) { const int k = kg + 32 * it;
#pragma unroll
        for (int r = 0; r < 9; ++r) acc[r] += S[r * 1024 + k] * w[it]; }
#pragma unroll
    for (int r = 0; r < 9; ++r) R[(kg * 16 + nn) * 9 + r] = acc[r];
    __syncthreads();
    if (tid < 144) { const int r = tid >> 4, n2 = tid & 15; float s = 0.f;
        for (int k2 = 0; k2 < 32; ++k2) s += R[(k2 * 16 + n2) * 9 + r];
        __hip_atomic_store((float*)(P.ws + WS_ADA) + r * 3072 + item * 16 + n2, s + P.ada_b[item * 16 + n2], __ATOMIC_RELAXED, __HIP_MEMORY_SCOPE_AGENT); }
    asm volatile("s_waitcnt vmcnt(0)" ::: "memory");
    __syncthreads();
    if (tid == 0) __hip_atomic_fetch_add((unsigned*)(P.ws + WS_ADA_CNT), 1u, __ATOMIC_RELAXED, __HIP_MEMORY_SCOPE_AGENT);
}
__device__ __forceinline__ void phase0(LAS unsigned char* lds, const Params& P) {
    for (int item = blockIdx.x; item < 192; item += gridDim.x) p0_ada_item(lds, P, item);
}
__device__ __forceinline__ int win_src_col(int nd) { const int t = nd >> 8, r = nd & 255; if (t < 8) return nd; if (t < 16) { const int j = t - 8; return r < 128 ? 2048 + 128 * j + r : 4096 + 128 * j + (r - 128); } return 3072 + (nd - 4096); }
template <bool REMAP = false>
__device__ __forceinline__ void p0_transpose_item(const float* W, int K, int N, bf16_t* WT, float scale, LAS float* scr, int item, int lane) {
    const int nblk = N / 32, kb = item / nblk, nb = item % nblk, k0 = 64 * kb, n0 = 32 * nb, ns0 = REMAP ? win_src_col(n0) : n0;
    float t[32];
#pragma unroll
    for (int i = 0; i < 32; ++i) t[i] = W[(size_t)(k0 + 2 * i + (lane >> 5)) * N + ns0 + (lane & 31)];
#pragma unroll
    for (int i = 0; i < 32; ++i) scr[(2 * i + (lane >> 5)) * 33 + (lane & 31)] = t[i] * scale;
    asm volatile("s_waitcnt lgkmcnt(0)" ::: "memory");
    const int c = lane & 7;
#pragma unroll
    for (int j = 0; j < 4; ++j) { const int n = (lane >> 3) + 8 * j; const LAS float* s = scr + (8 * c) * 33 + n;
        u32x4 o; o.x = cvt_pk_bf16(s[0 * 33], s[1 * 33]); o.y = cvt_pk_bf16(s[2 * 33], s[3 * 33]); o.z = cvt_pk_bf16(s[4 * 33], s[5 * 33]); o.w = cvt_pk_bf16(s[6 * 33], s[7 * 33]);
        *(u32x4*)(WT + (size_t)(n0 + n) * K + k0 + 8 * c) = o; }
    asm volatile("s_waitcnt lgkmcnt(0)" ::: "memory");
}

__device__ __forceinline__ void phase1(LAS unsigned char* lds, const Params& P) {
    const int tid = opaque_tid(), lane = tid & 63, wid = __builtin_amdgcn_readfirstlane(tid >> 6);
    const int G = gridDim.x;
    const int gw = blockIdx.x * NWAVES + wid, NGW = G * NWAVES;
    const float* ADA = (const float*)(P.ws + WS_ADA); bf16_t* HN = (bf16_t*)(P.ws + WS_HN);
    LAS float* scr = (LAS float*)(lds + wid * 16384);
    constexpr int I_IN = (DM / 64) * (DIN / 32), I_OUT = (2 * DM / 64) * (DM / 32), I_LRU = 32 * 8;
    bf16_t* WinT = (bf16_t*)(P.ws + WS_WINT); bf16_t* WoutT = (bf16_t*)(P.ws + WS_WOUTT); bf16_t* LruW = (bf16_t*)(P.ws + WS_LRUW);
    for (int it = gw; it < I_IN + I_OUT + I_LRU; it += NGW) {
        int r = it;
        if (r < I_IN) { p0_transpose_item<true>(P.w_in, DM, DIN, WinT, 1.0f, scr, r, lane); continue; } r -= I_IN;
        if (r < I_OUT) { p0_transpose_item(P.w_out, 2 * DM, DM, WoutT, 1.0f, scr, r, lane); continue; } r -= I_OUT;
        { const int mat = r >> 3, sub = r & 7, dir = mat >> 4, gate = (mat >> 3) & 1, h = mat & 7;
          const float* src = (gate ? P.lru_wx : P.lru_wa) + (size_t)(dir * 8 + h) * 16384;
          p0_transpose_item(src, 128, 128, LruW + (size_t)((dir * 2 + gate) * 8 + h) * 16384, -LOG2E, scr, sub, lane); }
    }
    bf16_t* SguW = (bf16_t*)(P.ws + WS_SGUW);
    for (int i = (blockIdx.x * NTHREADS + tid) * 4; i < 8 * 128 * 128; i += G * NTHREADS * 4) {
        const f32x4 v = *(const f32x4*)(P.sgu_w + i); u32x2 o; o.x = cvt_pk_bf16(v[0], v[1]); o.y = cvt_pk_bf16(v[2], v[3]); *(u32x2*)(SguW + i) = o; }
    if (wid == 0) { unsigned sp = 0;
        while ((unsigned)__builtin_amdgcn_readfirstlane(__hip_atomic_load((unsigned*)(P.ws + WS_ADA_CNT), __ATOMIC_RELAXED, __HIP_MEMORY_SCOPE_AGENT)) < 192u) { __builtin_amdgcn_s_sleep(1); if (++sp > (1u << 20)) break; }
        __builtin_amdgcn_fence(__ATOMIC_ACQUIRE, "agent");
        asm volatile("s_waitcnt vmcnt(0)" ::: "memory"); }
    __syncthreads();
    f32x4 ng[4];
#pragma unroll
    for (int j = 0; j < 4; ++j) ng[j] = *(const f32x4*)(P.norm_g + 4 * (lane + 64 * j));
    const int per = (MROWS + CROWS + NGW - 1) / NGW;
    for (int r0 = gw * per; r0 < (gw + 1) * per && r0 < MROWS + CROWS; r0 += 3) {
        f32x4 v[3][4], sh[3][4], sc[3][4];
#pragma unroll
        for (int u = 0; u < 3; ++u) { const int row = r0 + u < MROWS + CROWS ? r0 + u : MROWS + CROWS - 1;
            const float* src = row < MROWS ? P.x + (size_t)row * DM : P.ctx + (size_t)(row - MROWS) * DM;
            const int bi = row < MROWS ? row / SEQ : 8;
#pragma unroll
            for (int j = 0; j < 4; ++j) { v[u][j] = ((const f32x4*)src)[lane + 64 * j]; sh[u][j] = *(const f32x4*)(ADA + bi * 3072 + 4 * (lane + 64 * j)); sc[u][j] = *(const f32x4*)(ADA + bi * 3072 + 1024 + 4 * (lane + 64 * j)); } }
#pragma unroll
        for (int u = 0; u < 3; ++u) { const int row = r0 + u;
            float s = 0.f;
#pragma unroll
            for (int j = 0; j < 4; ++j) s += (v[u][j][0] * v[u][j][0] + v[u][j][1] * v[u][j][1]) + (v[u][j][2] * v[u][j][2] + v[u][j][3] * v[u][j][3]);
            const float rstd = 1.0f / sqrtf(wave_sum(s) * (1.0f / DM) + 1e-6f);
            if (row < (gw + 1) * per && row < MROWS + CROWS) {
                u32x2* o8 = (u32x2*)(HN + (size_t)row * DM) + lane;
#pragma unroll
                for (int j = 0; j < 4; ++j) { const f32x4 o = v[u][j] * rstd * ng[j] * (sc[u][j] + 1.0f) + sh[u][j];
                    u32x2 w; w.x = cvt_pk_bf16(o[0], o[1]); w.y = cvt_pk_bf16(o[2], o[3]); o8[64 * j] = w; } } }
    }
}

constexpr int XC_PITCH = 272;
struct LruTile { const bf16_t* src; int ld, L, t0; };
__device__ __forceinline__ LruTile lru_tile(const bf16_t* Z, const bf16_t* ZC, int b, int h, int dir, int sc) {
    LruTile t;
    if (sc == 0) { t.src = ZC + (size_t)b * CTXL * DM + h * 128; t.ld = DM; t.L = CTXL; t.t0 = 0; }
    else { const int chunk = dir == 0 ? sc - 1 : 8 - sc; t.src = Z + ZSLAB(h, (size_t)b * SEQ); t.ld = 128; t.L = SEQ; t.t0 = chunk * 256; }
    return t;
}
__device__ __forceinline__ void lru_load_rows(u32x4 (&rows)[11], const LruTile& T, int tr, int cgp) {
    const unsigned loff = (unsigned)(tr * 8 * T.ld + cgp * 8);
#pragma unroll
    for (int j = 0; j < 11; ++j) { const bf16_t* bj = T.src + (long)(T.t0 - 1 + j) * T.ld; rows[j] = *(const u32x4*)(bj + loff); }
}
constexpr int LRU_IO_OFF = 256 * XC_PITCH + 2048 + 64 * XC_PITCH + 2560;
constexpr int IO_NP = 80, IO_WP = 144;
template <int dir>
__device__ __forceinline__ void lru_pass(LAS unsigned char* lds, const Params& P, int b, int h, int q, bool dry) {
    const int tid = opaque_tid(), lane = tid & 63, wid = __builtin_amdgcn_readfirstlane(tid >> 6), g = lane >> 5, nl = lane & 31;
    const int chl = q * 32 + nl, ch = h * 128 + chl;
    LAS unsigned char* XC = lds;
    LAS float* AGG = (LAS float*)(lds + 256 * XC_PITCH);
    LAS unsigned char* WB = lds + 256 * XC_PITCH + 2048;
    LAS float* CWL = (LAS float*)(lds + 256 * XC_PITCH + 2048 + 64 * XC_PITCH);
    LAS unsigned char* TIN = lds + LRU_IO_OFF;
    LAS unsigned char* TOUT = lds + LRU_IO_OFF + 256 * (dir == 0 ? IO_NP : IO_WP);
    bf16_t* Z = (bf16_t*)(P.ws + WS_Z); const bf16_t* ZC = (const bf16_t*)(P.ws + WS_ZC); unsigned* HFW = (unsigned*)(P.ws + WS_HF);
    const bf16_t* LruW = (const bf16_t*)(P.ws + WS_LRUW);
    const int cgp = tid & 15, tr = tid >> 4;
    const int s_i = 16 * ((nl >> 2) & 1) + ((nl >> 3) << 2) + (nl & 3);
    const bf16_t* Zg = Z + ZSLAB(8 + h, (size_t)b * SEQ) + q * 32;
    unsigned* Hg = HFW + (size_t)b * SEQ * DM + h * 128 + q * 32;
    {
#pragma unroll
        for (int i = 0; i < 2; ++i) { const int idx = tid + i * NTHREADS, gate = idx >> 9, n = (idx >> 4) & 31, kc = idx & 15;
            *(LAS u32x4*)(WB + (gate * 32 + n) * XC_PITCH + kc * 16) = *(const u32x4*)(LruW + ((size_t)((dir * 2 + gate) * 8 + h) * 128 + q * 32 + n) * 128 + kc * 8); }
        const float br = -LOG2E * P.lru_ba[(dir * 8 + h) * 128 + chl], bi = -LOG2E * P.lru_bx[(dir * 8 + h) * 128 + chl];
        const float lam = P.lru_lambda[dir * 1024 + ch];
        const float cl = -8.0f * LOG2E * log1pf(__expf(-lam));
        float carry = 0.f;
        LruTile cur = lru_tile(Z, ZC, b, h, dir, 0);
        u32x4 rows[11];
        constexpr int NIN = dir == 0 ? 2 : 4;
        u32x4 inr[NIN];
        lru_load_rows(rows, cur, tr, cgp);
#pragma unroll
        for (int i = 0; i < NIN; ++i) inr[i] = (u32x4){0u, 0u, 0u, 0u};
        int t0_prev = 0;
        for (int sc = 0; sc < 9; ++sc) {
            const bool isctx = (sc == 0);
            const int t0 = cur.t0;
#pragma unroll
            for (int j = 0; j < 11; ++j) { if (j != 0 && j < 9) continue;
                const int t = t0 + tr * 8 - 1 + j; if (t < 0 || t >= cur.L) rows[j] = (u32x4){0u, 0u, 0u, 0u}; }
            f32x2 cw2[4][4], cb2[4];
#pragma unroll
            for (int k = 0; k < 5; ++k) { const f32x4 a = *(const LAS f32x4*)(CWL + k * 128 + cgp * 8), c2 = *(const LAS f32x4*)(CWL + k * 128 + cgp * 8 + 4);
                if (k < 4) { cw2[k][0] = (f32x2){a[0], a[1]}; cw2[k][1] = (f32x2){a[2], a[3]}; cw2[k][2] = (f32x2){c2[0], c2[1]}; cw2[k][3] = (f32x2){c2[2], c2[3]}; }
                else { cb2[0] = (f32x2){a[0], a[1]}; cb2[1] = (f32x2){a[2], a[3]}; cb2[2] = (f32x2){c2[0], c2[1]}; cb2[3] = (f32x2){c2[2], c2[3]}; } }
#pragma unroll
            for (int j = 0; j < 8; ++j) {
                f32x2 o0 = cb2[0], o1 = cb2[1], o2 = cb2[2], o3 = cb2[3];
#pragma unroll
                for (int k = 0; k < 4; ++k) { const u32x4 rr = rows[j + k];
                    o0 = cw2[k][0] * (f32x2){bf_lo(rr.x), bf_hi(rr.x)} + o0; o1 = cw2[k][1] * (f32x2){bf_lo(rr.y), bf_hi(rr.y)} + o1;
                    o2 = cw2[k][2] * (f32x2){bf_lo(rr.z), bf_hi(rr.z)} + o2; o3 = cw2[k][3] * (f32x2){bf_lo(rr.w), bf_hi(rr.w)} + o3; }
                u32x4 w; w.x = cvt_pk_bf16(o0[0], o0[1]); w.y = cvt_pk_bf16(o1[0], o1[1]); w.z = cvt_pk_bf16(o2[0], o2[1]); w.w = cvt_pk_bf16(o3[0], o3[1]);
                *(LAS u32x4*)(XC + (tr * 8 + j) * XC_PITCH + cgp * 16) = w;
            }
#pragma unroll
            for (int i = 0; i < NIN; ++i) { const int id = tid + i * NTHREADS;
                if (dir == 0) *(LAS u32x4*)(TIN + (id >> 2) * IO_NP + (id & 3) * 16) = inr[i];
                else *(LAS u32x4*)(TIN + (id >> 3) * IO_WP + (id & 7) * 16) = inr[i]; }
            LruTile nxt = cur;
            if (sc < 8) { nxt = lru_tile(Z, ZC, b, h, dir, sc + 1); lru_load_rows(rows, nxt, tr, cgp);
#pragma unroll
                for (int i = 0; i < NIN; ++i) { const int id = tid + i * NTHREADS;
                    if (dir == 0) inr[i] = *(const u32x4*)(Zg + (size_t)(nxt.t0 + (id >> 2)) * 128 + (id & 3) * 8);
                    else inr[i] = *(const u32x4*)(Hg + (size_t)(nxt.t0 + (id >> 3)) * DM + (id & 7) * 4); } }
            LDS_BARRIER();
            if (sc >= 2) {
                if (dir == 0) {
#pragma unroll
                    for (int i = 0; i < 4; ++i) { const int id = tid + i * NTHREADS; *(u32x4*)(Hg + (size_t)(t0_prev + (id >> 3)) * DM + (id & 7) * 4) = *(const LAS u32x4*)(TOUT + (id >> 3) * IO_WP + (id & 7) * 16); }
                } else if (!dry) {
#pragma unroll
                    for (int i = 0; i < 2; ++i) { const int id = tid + i * NTHREADS; *(u32x4*)(Z + ZSLAB(8 + h, (size_t)b * SEQ + t0_prev + (id >> 2)) + q * 32 + (id & 3) * 8) = *(const LAS u32x4*)(TOUT + (id >> 2) * IO_NP + (id & 3) * 16); }
                }
            }
            f32x16 zr, zi;
#pragma unroll
            for (int v = 0; v < 16; ++v) { zr[v] = br; zi[v] = bi; }
            const int sbase = 32 * wid + 16 * g;
            { const int sl = 32 * wid + s_i; const int tlA = dir == 0 ? sl : 255 - sl;
              const LAS unsigned char* ap = XC + tlA * XC_PITCH + 16 * g;
              const LAS unsigned char* wrp = WB + nl * XC_PITCH + 16 * g; const LAS unsigned char* wip = wrp + 32 * XC_PITCH;
#pragma unroll
              for (int ks = 0; ks < 8; ++ks) { const bf16x8 A = *(const LAS bf16x8*)(ap + 32 * ks);
                  const bf16x8 Br = *(const LAS bf16x8*)(wrp + 32 * ks), Bi = *(const LAS bf16x8*)(wip + 32 * ks);
                  zr = __builtin_amdgcn_mfma_f32_32x32x16_bf16(A, Br, zr, 0, 0, 0); zi = __builtin_amdgcn_mfma_f32_32x32x16_bf16(A, Bi, zi, 0, 0, 0); } }
            unsigned xcb[16], pk[16];
#pragma unroll
            for (int v = 0; v < 16; ++v) { const int s = sbase + v; const int tl = dir == 0 ? s : 255 - s; xcb[v] = *(const LAS bf16_t*)(XC + tl * XC_PITCH + chl * 2);
                if (dir == 0) pk[v] = *(const LAS bf16_t*)(TIN + tl * IO_NP + nl * 2); else pk[v] = *(const LAS unsigned*)(TIN + tl * IO_WP + nl * 4); }
            float Pp = 1.f, E = 0.f;
#pragma unroll
            for (int v = 0; v < 16; ++v) {
                const float xcv = __uint_as_float(xcb[v] << 16);
                const float r = __builtin_amdgcn_rcpf(1.0f + __builtin_amdgcn_exp2f(zr[v]));
                const float ig = __builtin_amdgcn_rcpf(1.0f + __builtin_amdgcn_exp2f(zi[v]));
                const float a = __builtin_amdgcn_exp2f(cl * r);
                const float sq = __builtin_amdgcn_sqrtf(fmaf(-a, a, 1.0f));
                const float u = sq * ig * xcv;
                E = fmaf(a, E, u); Pp *= a; zr[v] = E; zi[v] = Pp; }
            const float Po = __shfl_xor(Pp, 32), Eo = __shfl_xor(E, 32);
            const float P0 = g ? Po : Pp, E0 = g ? Eo : E, P1 = g ? Pp : Po, E1 = g ? E : Eo;
            if (g == 0) { AGG[(wid * 2 + 0) * 32 + nl] = P0 * P1; AGG[(wid * 2 + 1) * 32 + nl] = fmaf(P1, E0, E1); }
            LDS_BARRIER();
            float cin = carry, cend = carry;
#pragma unroll
            for (int w = 0; w < 8; ++w) { const float pw = AGG[(w * 2 + 0) * 32 + nl], ew = AGG[(w * 2 + 1) * 32 + nl]; if (w == wid) cin = cend; cend = fmaf(pw, cend, ew); }
            carry = cend;
            if (g) cin = fmaf(P0, cin, E0);
            if (!isctx) {
#pragma unroll
                for (int v = 0; v < 16; ++v) { const float hv = fmaf(zi[v], cin, zr[v]);
                    const int s = sbase + v; const int tl = dir == 0 ? s : 255 - s;
                    if (dir == 0) *(LAS unsigned*)(TOUT + tl * IO_WP + nl * 4) = (cvt_pk_bf16(hv, 0.f) & 0xffffu) | (pk[v] << 16);
                    else *(LAS bf16_t*)(TOUT + tl * IO_NP + nl * 2) = f2bf((bf_lo(pk[v]) + hv) * bf_hi(pk[v])); }
            }
            t0_prev = t0;
            cur = nxt;
        }
        LDS_BARRIER();
        if (dir == 0) {
#pragma unroll
            for (int i = 0; i < 4; ++i) { const int id = tid + i * NTHREADS; *(u32x4*)(Hg + (size_t)(t0_prev + (id >> 3)) * DM + (id & 7) * 4) = *(const LAS u32x4*)(TOUT + (id >> 3) * IO_WP + (id & 7) * 16); }
        } else if (!dry) {
#pragma unroll
            for (int i = 0; i < 2; ++i) { const int id = tid + i * NTHREADS; *(u32x4*)(Z + ZSLAB(8 + h, (size_t)b * SEQ + t0_prev + (id >> 2)) + q * 32 + (id & 3) * 8) = *(const LAS u32x4*)(TOUT + (id >> 2) * IO_NP + (id & 3) * 16); }
        }
    }
}
__device__ __forceinline__ void lru_strip(LAS unsigned char* lds, const Params& P, int strip, bool dry) {
    const int tid = opaque_tid();
    const int b = strip >> 5, h = (strip >> 2) & 7, q = strip & 3;
    LAS float* CWL = (LAS float*)(lds + 256 * XC_PITCH + 2048 + 64 * XC_PITCH);
    for (int i = tid; i < 640; i += NTHREADS) { const int k = i >> 7, c = i & 127; CWL[i] = k < 4 ? P.conv_w[k * 1024 + h * 128 + c] : P.conv_b[h * 128 + c]; }
    LDS_BARRIER();
    lru_pass<0>(lds, P, b, h, q, dry);
    asm volatile("s_waitcnt vmcnt(0)" ::: "memory"); __syncthreads();
    if (tid < 64) { __builtin_amdgcn_fence(__ATOMIC_ACQUIRE, "agent"); asm volatile("s_waitcnt vmcnt(0)" ::: "memory"); }
    __syncthreads();
    lru_pass<1>(lds, P, b, h, q, dry);
    __syncthreads();
}

constexpr int VT_PITCH = 272;
struct SguRegs { unsigned vw[16]; u32x4 uu[4]; float lg0, lg1, lb0, lb1; };
__device__ __forceinline__ void sgu_load(SguRegs& R, const Params& P, const bf16_t* Z, size_t R0, int gg, int tid) {
    const int cp = tid & 63, tg = tid >> 6, c0 = 2 * cp;
#pragma unroll
    for (int half = 0; half < 2; ++half)
#pragma unroll
        for (int j = 0; j < 8; ++j) R.vw[half * 8 + j] = *(const unsigned*)(Z + ZSLAB(24 + gg, R0 + half * 64 + tg * 8 + j) + c0);
    const int rr = tid >> 4, cc = (tid & 15) * 8;
#pragma unroll
    for (int i = 0; i < 4; ++i) { const bf16_t* zp = Z + ZSLAB(16 + gg, R0 + rr + 32 * i) + cc; R.uu[i] = *(const u32x4*)zp; }
    R.lg0 = P.sgu_ln_g[gg * 128 + c0]; R.lg1 = P.sgu_ln_g[gg * 128 + c0 + 1]; R.lb0 = P.sgu_ln_b[gg * 128 + c0]; R.lb1 = P.sgu_ln_b[gg * 128 + c0 + 1];
}
__device__ __forceinline__ unsigned mul_pk_bf16(unsigned a, unsigned b) { return cvt_pk_bf16(bf_lo(a) * bf_lo(b), bf_hi(a) * bf_hi(b)); }
__device__ __forceinline__ void sgu_item(LAS unsigned char* lds, const Params& P, int item, bool dry) {
    const int tid = opaque_tid(), lane = tid & 63, wid = __builtin_amdgcn_readfirstlane(tid >> 6);
    const int b = item >> 5, chunk = (item >> 1) & 15, gh = item & 1;
    const size_t R0 = (size_t)b * SEQ + chunk * 128;
    LAS unsigned char* VT = lds;
    LAS unsigned char* UG = lds + 128 * VT_PITCH;
    LAS float* ST = (LAS float*)(lds + 2 * 128 * VT_PITCH);
    bf16_t* Z = (bf16_t*)(P.ws + WS_Z); const bf16_t* SguW = (const bf16_t*)(P.ws + WS_SGUW);
    SguRegs R;
    sgu_load(R, P, Z, R0, gh * 4, tid);
    if (tid < 128) { const f32x4* sp = (const f32x4*)((const float*)(P.ws + WS_STATS) + (R0 + tid) * 32); float s = 0.f, ss = 0.f;
#pragma unroll
        for (int k = 0; k < 8; ++k) { const f32x4 v = sp[k]; s += v[0] + v[2]; ss += v[1] + v[3]; }
        const float mean = s * (1.0f / 1024.0f), var = fmaxf(ss * (1.0f / 1024.0f) - mean * mean, 0.f);
        ST[tid * 2] = mean; ST[tid * 2 + 1] = 1.0f / sqrtf(var + 1e-5f); }
    LDS_BARRIER();
    const int cp = tid & 63, tg = tid >> 6, c0 = 2 * cp;
    const int rr = tid >> 4, cc = (tid & 15) * 8;
    const int pb = wid & 3, cb0 = (wid >> 2) * 2, ml = lane & 31, kh = lane >> 5;
    for (int gi = 0; gi < 4; ++gi) {
        const int gg = gh * 4 + gi;
#pragma unroll
        for (int half = 0; half < 2; ++half) { const int tb = half * 64 + tg * 8;
            float v0[8], v1[8];
#pragma unroll
            for (int j = 0; j < 8; ++j) { const float mean = ST[(tb + j) * 2], rs = ST[(tb + j) * 2 + 1]; const unsigned w = R.vw[half * 8 + j];
                v0[j] = (bf_lo(w) - mean) * rs * R.lg0 + R.lb0; v1[j] = (bf_hi(w) - mean) * rs * R.lg1 + R.lb1; }
            u32x4 o0, o1;
            o0.x = cvt_pk_bf16(v0[0], v0[1]); o0.y = cvt_pk_bf16(v0[2], v0[3]); o0.z = cvt_pk_bf16(v0[4], v0[5]); o0.w = cvt_pk_bf16(v0[6], v0[7]);
            o1.x = cvt_pk_bf16(v1[0], v1[1]); o1.y = cvt_pk_bf16(v1[2], v1[3]); o1.z = cvt_pk_bf16(v1[4], v1[5]); o1.w = cvt_pk_bf16(v1[6], v1[7]);
            *(LAS u32x4*)(VT + c0 * VT_PITCH + tb * 2) = o0; *(LAS u32x4*)(VT + (c0 + 1) * VT_PITCH + tb * 2) = o1; }
#pragma unroll
        for (int i = 0; i < 4; ++i) { const u32x4 w = R.uu[i];
            *(LAS u32x4*)(UG + (rr + 32 * i) * VT_PITCH + cc * 2) = w; }
        if (gi < 3) sgu_load(R, P, Z, R0, gg + 1, tid);
        LDS_BARRIER();
        bf16x8 Aw[8];
        { const bf16_t* ap = SguW + ((size_t)gg * 128 + pb * 32 + ml) * 128 + 8 * kh;
#pragma unroll
          for (int ks = 0; ks < 8; ++ks) Aw[ks] = *(const bf16x8*)(ap + 16 * ks); }
        float bsv[16];
#pragma unroll
        for (int v = 0; v < 16; ++v) bsv[v] = P.sgu_b[gg * 128 + pb * 32 + (v & 3) + 8 * (v >> 2) + 4 * kh];
#pragma unroll
        for (int cbi = 0; cbi < 2; ++cbi) { const int ccol = (cb0 + cbi) * 32 + ml;
            f32x16 acc;
#pragma unroll
            for (int v = 0; v < 16; ++v) acc[v] = 0.f;
            const LAS unsigned char* bp = VT + ccol * VT_PITCH + 16 * kh;
#pragma unroll
            for (int ks = 0; ks < 8; ++ks) { const bf16x8 Bf = *(const LAS bf16x8*)(bp + 32 * ks); acc = __builtin_amdgcn_mfma_f32_32x32x16_bf16(Aw[ks], Bf, acc, 0, 0, 0); }
#pragma unroll
            for (int v = 0; v < 16; ++v) { const int p = pb * 32 + (v & 3) + 8 * (v >> 2) + 4 * kh;
                LAS bf16_t* up = (LAS bf16_t*)(UG + p * VT_PITCH + ccol * 2);
                *up = f2bf(bf2f(*up) * (acc[v] + bsv[v])); } }
        LDS_BARRIER();
        if (!dry) {
#pragma unroll
            for (int i = 0; i < 4; ++i) *(u32x4*)(Z + ZSLAB(16 + gg, R0 + rr + 32 * i) + cc) = *(const LAS u32x4*)(UG + (rr + 32 * i) * VT_PITCH + cc * 2); }
    }
    LDS_BARRIER();
}

__device__ __forceinline__ void sgu_list(LAS unsigned char* lds, const Params& P, int i0, int istride) {
    const int tid = opaque_tid(), lane = tid & 63, wid = __builtin_amdgcn_readfirstlane(tid >> 6);
    if (i0 >= 1024) return;
    LAS unsigned char* VT = lds;
    LAS unsigned char* UG = lds + 128 * VT_PITCH;
    LAS float* ST = (LAS float*)(lds + 2 * 128 * VT_PITCH);
    bf16_t* Z = (bf16_t*)(P.ws + WS_Z); const bf16_t* SguW = (const bf16_t*)(P.ws + WS_SGUW);
    SguRegs R;
    sgu_load(R, P, Z, (size_t)(i0 >> 7) * SEQ + ((i0 >> 3) & 15) * 128, i0 & 7, tid);
    const int cp = tid & 63, tg = tid >> 6, c0 = 2 * cp;
    const int rr = tid >> 4, cc = (tid & 15) * 8;
    const int pb = wid & 3, cb0 = (wid >> 2) * 2, ml = lane & 31, kh = lane >> 5;
    for (int i = i0; i < 1024; i += istride) {
        const int gg = i & 7; const size_t R0 = (size_t)(i >> 7) * SEQ + ((i >> 3) & 15) * 128;
        if (tid < 128) { const f32x4* sp = (const f32x4*)((const float*)(P.ws + WS_STATS) + (R0 + tid) * 32); float s1 = 0.f, ss = 0.f;
#pragma unroll
            for (int k = 0; k < 8; ++k) { const f32x4 v = sp[k]; s1 += v[0] + v[2]; ss += v[1] + v[3]; }
            const float mean = s1 * (1.0f / 1024.0f), var = fmaxf(ss * (1.0f / 1024.0f) - mean * mean, 0.f);
            ST[tid * 2] = mean; ST[tid * 2 + 1] = 1.0f / sqrtf(var + 1e-5f); }
        LDS_BARRIER();
#pragma unroll
        for (int half = 0; half < 2; ++half) { const int tb = half * 64 + tg * 8;
            float v0[8], v1[8];
#pragma unroll
            for (int j = 0; j < 8; ++j) { const float mean = ST[(tb + j) * 2], rs = ST[(tb + j) * 2 + 1]; const unsigned w = R.vw[half * 8 + j];
                v0[j] = (bf_lo(w) - mean) * rs * R.lg0 + R.lb0; v1[j] = (bf_hi(w) - mean) * rs * R.lg1 + R.lb1; }
            u32x4 o0, o1;
            o0.x = cvt_pk_bf16(v0[0], v0[1]); o0.y = cvt_pk_bf16(v0[2], v0[3]); o0.z = cvt_pk_bf16(v0[4], v0[5]); o0.w = cvt_pk_bf16(v0[6], v0[7]);
            o1.x = cvt_pk_bf16(v1[0], v1[1]); o1.y = cvt_pk_bf16(v1[2], v1[3]); o1.z = cvt_pk_bf16(v1[4], v1[5]); o1.w = cvt_pk_bf16(v1[6], v1[7]);
            *(LAS u32x4*)(VT + c0 * VT_PITCH + tb * 2) = o0; *(LAS u32x4*)(VT + (c0 + 1) * VT_PITCH + tb * 2) = o1; }
#pragma unroll
        for (int k = 0; k < 4; ++k) *(LAS u32x4*)(UG + (rr + 32 * k) * VT_PITCH + cc * 2) = R.uu[k];
        { const int inx = i + istride; if (inx < 1024) sgu_load(R, P, Z, (size_t)(inx >> 7) * SEQ + ((inx >> 3) & 15) * 128, inx & 7, tid); }
        LDS_BARRIER();
        bf16x8 Aw[8];
        { const bf16_t* ap = SguW + ((size_t)gg * 128 + pb * 32 + ml) * 128 + 8 * kh;
#pragma unroll
          for (int ks = 0; ks < 8; ++ks) Aw[ks] = *(const bf16x8*)(ap + 16 * ks); }
        float bsv[16];
#pragma unroll
        for (int v = 0; v < 16; ++v) bsv[v] = P.sgu_b[gg * 128 + pb * 32 + (v & 3) + 8 * (v >> 2) + 4 * kh];
#pragma unroll
        for (int cbi = 0; cbi < 2; ++cbi) { const int ccol = (cb0 + cbi) * 32 + ml;
            f32x16 acc;
#pragma unroll
            for (int v = 0; v < 16; ++v) acc[v] = 0.f;
            const LAS unsigned char* bp = VT + ccol * VT_PITCH + 16 * kh;
#pragma unroll
            for (int ks = 0; ks < 8; ++ks) { const bf16x8 Bf = *(const LAS bf16x8*)(bp + 32 * ks); acc = __builtin_amdgcn_mfma_f32_32x32x16_bf16(Aw[ks], Bf, acc, 0, 0, 0); }
#pragma unroll
            for (int v = 0; v < 16; ++v) { const int p = pb * 32 + (v & 3) + 8 * (v >> 2) + 4 * kh;
                LAS bf16_t* up = (LAS bf16_t*)(UG + p * VT_PITCH + ccol * 2);
                *up = f2bf(bf2f(*up) * (acc[v] + bsv[v])); } }
        LDS_BARRIER();
#pragma unroll
        for (int k = 0; k < 4; ++k) *(u32x4*)(Z + ZSLAB(16 + gg, R0 + rr + 32 * k) + cc) = *(const LAS u32x4*)(UG + (rr + 32 * k) * VT_PITCH + cc * 2);
    }
    LDS_BARRIER();
}

__device__ __forceinline__ void phase5(const Params& P) {
    const int tid = opaque_tid(), lane = tid & 63, wid = tid >> 6;
    const int gw = blockIdx.x * NWAVES + wid, NGW = gridDim.x * NWAVES;
    const float* RS = (const float*)(P.ws + WS_ROWSS);
    for (int row = gw; row < MROWS; row += NGW) {
        f32x4* xr = (f32x4*)(P.out + (size_t)row * DM) + lane;
        f32x4 v[4];
#pragma unroll
        for (int j = 0; j < 4; ++j) v[j] = xr[64 * j];
        float ss = RS[(size_t)row * 16 + (lane & 15)];
        ss += __shfl_xor(ss, 1); ss += __shfl_xor(ss, 2); ss += __shfl_xor(ss, 4); ss += __shfl_xor(ss, 8);
        const float rstd = 1.0f / sqrtf(ss * (1.0f / DM) + 1e-6f);
#pragma unroll
        for (int j = 0; j < 4; ++j) { const f32x4 fg = *(const f32x4*)(P.final_g + 4 * (lane + 64 * j)); xr[64 * j] = v[j] * rstd * fg; }
    }
}

constexpr int LDS_BYTES = 155648;
static_assert(LRU_IO_OFF + 256 * (IO_NP + IO_WP) <= LDS_BYTES - 16, "LRU LDS map");
__global__ void __launch_bounds__(NTHREADS, 2) fwd_megakernel(Params P) {
    extern __shared__ __attribute__((aligned(16))) unsigned char smem[];
    LAS unsigned char* lds = (LAS unsigned char*)smem;
    cg::grid_group grid = cg::this_grid();
    const int lo = P.ph_lo, hi = P.ph_hi;
    volatile LAS unsigned* bst = (volatile LAS unsigned*)(lds + LDS_BYTES - 16);
    if (threadIdx.x < 2) bst[threadIdx.x] = 0u;
    __syncthreads();
    XcdBarrier xbar = xcd_barrier_post((unsigned*)(P.ws + WS_BAR), bst);
    if (lo > 1000) grid.sync();
#define IN(k) (lo <= (k) && (k) < hi)
#define SEAM(k) do { if (IN(k) && IN((k) + 1)) xcd_barrier(xbar); } while (0)
    if (IN(0)) for (int r = 0; r < P.rep0; ++r) { phase0(lds, P); __syncthreads(); }
    if (IN(1)) for (int r = 0; r < P.rep1; ++r) { phase1(lds, P); __syncthreads(); }
    SEAM(1);
    if (IN(2)) for (int r = 0; r < P.rep2; ++r) {
        pg8::Gemm g{(const bf16_t*)(P.ws + WS_HN), (const bf16_t*)(P.ws + WS_WINT), DM, DM, 256};
        pg8::StaticOrder S; S.init(MROWS, DIN, (int)gridDim.x, (int)blockIdx.x);
        pg8::EpiInProj E{(bf16_t*)(P.ws + WS_Z), (bf16_t*)(P.ws + WS_ZC), (float*)(P.ws + WS_STATS)};
        pg8::gemm_phase<pg8::EpiInProj, pg8::StaticOrder>(lds, g, S, E);
    }
    SEAM(2);
    if (IN(3)) {
        const int G = (int)gridDim.x, bx = (int)blockIdx.x, ctxB = G < 32 ? G : 32;
        if (bx < ctxB) {
            pg8::Gemm g{(const bf16_t*)(P.ws + WS_HN) + (size_t)MROWS * DM, (const bf16_t*)(P.ws + WS_WINT), DM, DM, 256};
            pg8::StaticOrder S; S.init(CROWS, DM, ctxB, bx);
            pg8::EpiCtx EC{pg8::EpiInProj{(bf16_t*)(P.ws + WS_Z), (bf16_t*)(P.ws + WS_ZC), (float*)(P.ws + WS_STATS)}};
            pg8::gemm_phase<pg8::EpiCtx, pg8::StaticOrder>(lds, g, S, EC);
            __syncthreads();
            if (threadIdx.x == 0) {
                __hip_atomic_fetch_add((unsigned*)(P.ws + WS_CTX_CNT), 1u, __ATOMIC_RELAXED, __HIP_MEMORY_SCOPE_AGENT); }
            if (G <= ctxB) sgu_list(lds, P, bx, G);
        } else sgu_list(lds, P, bx - ctxB, G - ctxB);
        __syncthreads();
        if (threadIdx.x < 64) { unsigned sp = 0;
            while ((unsigned)__builtin_amdgcn_readfirstlane(__hip_atomic_load((unsigned*)(P.ws + WS_CTX_CNT), __ATOMIC_RELAXED, __HIP_MEMORY_SCOPE_AGENT)) < (unsigned)ctxB) { __builtin_amdgcn_s_sleep(1); if (++sp > (1u << 20)) break; }
            __builtin_amdgcn_fence(__ATOMIC_ACQUIRE, "agent");
            asm volatile("s_waitcnt vmcnt(0)" ::: "memory"); }
        __syncthreads();
        for (int s2 = bx; s2 < 256; s2 += G) { lru_strip(lds, P, ((s2 & 7) << 5) | (s2 >> 3), false); __syncthreads(); }
    }
    SEAM(3);
    const bool fuse_norm = (gridDim.x == 256);
    if (IN(4)) {
        pg8::Gemm g{(const bf16_t*)(P.ws + WS_Z) + ZSLAB(8, 0), (const bf16_t*)(P.ws + WS_WOUTT), 128, 2 * DM, ZSLAB(1, 0) * 2};
        pg8::StaticOrder S; S.init(MROWS, DM, (int)gridDim.x, (int)blockIdx.x);
        if (fuse_norm) {
            pg8::EpiOutFused E{P.x, (const float*)(P.ws + WS_ADA), P.final_g, P.out, (float*)(P.ws + WS_ROWSS), (unsigned*)(P.ws + WS_BAR + 16384)};
            pg8::gemm_phase<pg8::EpiOutFused, pg8::StaticOrder>(lds, g, S, E);
        } else {
            pg8::EpiOut E{P.x, (const float*)(P.ws + WS_ADA), P.out, (float*)(P.ws + WS_ROWSS)};
            pg8::gemm_phase<pg8::EpiOut, pg8::StaticOrder>(lds, g, S, E);
        }
    }
    if (!fuse_norm) {
        SEAM(4);
        if (IN(5)) phase5(P);
    }
#undef IN
#undef SEAM
}

#define PROBE_REP0 1
#define PROBE_REP1 1
#define PROBE_REP2 1
#define PROBE_REP3A 1
#define PROBE_REP3B 1
#define PROBE_REP4 1
#ifndef MK_N_LAUNCHES
#define MK_N_LAUNCHES 1
#endif

extern "C" void kernel_launch(void* const* d_in, const int* in_sizes, int n_in, void* d_out, int out_size, void* d_ws, size_t ws_size, hipStream_t stream) {
    static int grid = 0;
    if (grid == 0) {
        if (n_in != 21 || out_size != MROWS * DM || ws_size < WS_END) { fprintf(stderr, "kernel_launch: unexpected shapes (n_in %d out %d ws %zu)\n", n_in, out_size, ws_size); grid = -1; return; }
        int dev = 0, cus = 0, per_cu = 0;
        hipGetDevice(&dev);
        hipDeviceGetAttribute(&cus, hipDeviceAttributeMultiprocessorCount, dev);
        if (hipFuncSetAttribute((const void*)fwd_megakernel, hipFuncAttributeMaxDynamicSharedMemorySize, LDS_BYTES) != hipSuccess) { fprintf(stderr, "kernel_launch: hipFuncSetAttribute failed\n"); grid = -1; return; }
        if (hipOccupancyMaxActiveBlocksPerMultiprocessor(&per_cu, (const void*)fwd_megakernel, NTHREADS, LDS_BYTES) != hipSuccess || per_cu < 1) { fprintf(stderr, "kernel_launch: occupancy query failed (%d)\n", per_cu); (void)hipGetLastError(); grid = -1; return; }
        grid = cus;
    }
    if (grid < 0) return;
    Params p{};
    const float** f = (const float**)&p;
    for (int i = 0; i < 21; ++i) f[i] = (const float*)d_in[i];
    p.out = (float*)d_out; p.ws = (unsigned char*)d_ws;
    p.rep0 = PROBE_REP0; p.rep1 = PROBE_REP1; p.rep2 = PROBE_REP2; p.rep3a = PROBE_REP3A; p.rep3b = PROBE_REP3B; p.rep4 = PROBE_REP4;
    if (hipMemsetAsync((char*)d_ws + WS_BAR, 0, WS_BAR_BYTES, stream) != hipSuccess) { fprintf(stderr, "kernel_launch: memset failed\n"); return; }
#if MK_N_LAUNCHES == 1
    p.ph_lo = 0; p.ph_hi = 6;
    void* args[] = {&p};
    hipError_t e = hipLaunchCooperativeKernel((void*)fwd_megakernel, dim3(grid), dim3(NTHREADS), args, LDS_BYTES, stream);
    if (e != hipSuccess) fprintf(stderr, "kernel_launch: cooperative launch failed: %s (grid %d)\n", hipGetErrorString(e), grid);
#else
    for (int ph = 0; ph < 6; ++ph) { p.ph_lo = ph; p.ph_hi = ph + 1; hipLaunchKernelGGL(fwd_megakernel, dim3(grid), dim3(NTHREADS), LDS_BYTES, stream, p); }
#endif
}
```
